# Optimizing an MI355X kernel written in HIP

```python
import jax, jax.numpy as jnp
from jax import lax
import numpy as np

D_MODEL = 1024
BATCH = 4
SEQ = 4096
DEPTH = 1
DEC_BATCH = 128
DEC_SEQ = 4
PAST_LEN = 8192
PAGE_SIZE = 128

N_META = 16
RET_HEADS = 4
RET_DK = 128
RET_DV = 128
RET_CHUNK = 128
MLA_HEADS = 4
Q_LORA = 384
KV_LORA = 256
QK_NOPE = 128
QK_ROPE = 64
V_DIM = 128
D_FF = 2816
CONV_W = 3
ATTN_BLOCK = 128
ROPE_THETA = 10000.0
EPS = 1e-6
RET_W = RET_HEADS * RET_DV
MLA_W = MLA_HEADS * V_DIM
MIX_W = RET_W + MLA_W
SOFTMAX_SCALE = (QK_NOPE + QK_ROPE) ** -0.5
IN_WIDTHS = (RET_HEADS * RET_DK, RET_HEADS * RET_DK, RET_W, RET_W, Q_LORA, KV_LORA, QK_ROPE)
IN_W = sum(IN_WIDTHS)
IN_SPLITS = tuple(int(s) for s in np.cumsum(IN_WIDTHS)[:-1])

kernel_name = 'hybrid_retention_mla_convffn_step'


def rmsnorm(x, g):
    xf = x.astype(jnp.float32)
    y = xf * lax.rsqrt(jnp.mean(xf * xf, axis=-1, keepdims=True) + EPS)
    return (y * g.astype(jnp.float32)).astype(x.dtype)


def rope(x, pos):
    d = x.shape[-1]
    inv = ROPE_THETA ** (-jnp.arange(0, d, 2, dtype=jnp.float32) / d)
    ang = pos.astype(jnp.float32)[:, None] * inv[None, :]
    cos = jnp.cos(ang)[:, None, :]
    sin = jnp.sin(ang)[:, None, :]
    xf = x.astype(jnp.float32)
    x1, x2 = xf[..., : d // 2], xf[..., d // 2:]
    return jnp.concatenate([x1 * cos - x2 * sin, x1 * sin + x2 * cos], axis=-1).astype(x.dtype)


def retention_log_decay():
    return jnp.log1p(-jnp.exp2(-5.0 - jnp.arange(RET_HEADS, dtype=jnp.float32)))


def mixer_inputs(h, pos, w_in, g_q, w_uq, g_kv, w_uk):
    B, T, _ = h.shape
    z = h @ w_in
    q_r, k_r, v_r, g_r, c_q, c_kv, k_pe = jnp.split(z, IN_SPLITS, axis=-1)
    q_r = rope(q_r.reshape(B, T, RET_HEADS, RET_DK), pos)
    k_r = rope(k_r.reshape(B, T, RET_HEADS, RET_DK), pos) * (RET_DK ** -0.5)
    v_r = v_r.reshape(B, T, RET_HEADS, RET_DV)
    q = (rmsnorm(c_q, g_q) @ w_uq).reshape(B, T, MLA_HEADS, QK_NOPE + QK_ROPE)
    q_pe = rope(q[..., QK_NOPE:], pos)
    q_lat = jnp.einsum('bthn,chn->bthc', q[..., :QK_NOPE], w_uk)
    c_kv = rmsnorm(c_kv, g_kv)
    k_pe = rope(k_pe[:, :, None, :], pos)[:, :, 0, :]
    return q_r, k_r, v_r, g_r, q_lat, q_pe, c_kv, k_pe


def retention_chunk(state, q, k, v, log_gamma):
    L = q.shape[1]
    n = jnp.arange(L, dtype=jnp.float32)
    diff = n[:, None] - n[None, :]
    decay = jnp.where(diff >= 0, jnp.exp(log_gamma[:, None, None] * jnp.maximum(diff, 0.0)), 0.0)
    qf, kf, vf = q.astype(jnp.float32), k.astype(jnp.float32), v.astype(jnp.float32)
    scores = jnp.einsum('blhd,bmhd->bhlm', qf, kf) * decay[None]
    inner = jnp.einsum('bhlm,bmhe->blhe', scores, vf)
    q_dec = qf * jnp.exp((n + 1.0)[:, None] * log_gamma[None, :])[None, :, :, None]
    cross = jnp.einsum('blhd,bhde->blhe', q_dec, state)
    k_dec = kf * jnp.exp((L - 1.0 - n)[:, None] * log_gamma[None, :])[None, :, :, None]
    new_state = jnp.exp(L * log_gamma)[None, :, None, None] * state + jnp.einsum('blhd,blhe->bhde', k_dec, vf)
    return new_state, inner + cross


def retention_prompt(q, k, v, log_gamma):
    B, T = q.shape[0], q.shape[1]
    state0 = jnp.zeros((B, RET_HEADS, RET_DK, RET_DV), jnp.float32)
    state, o_meta = retention_chunk(state0, q[:, :N_META], k[:, :N_META], v[:, :N_META], log_gamma)
    nc = (T - N_META) // RET_CHUNK

    def to_chunks(a):
        return a[:, N_META:].reshape(B, nc, RET_CHUNK, a.shape[2], a.shape[3]).swapaxes(0, 1)

    def step(s, xs):
        return retention_chunk(s, xs[0], xs[1], xs[2], log_gamma)

    state, o = lax.scan(step, state, (to_chunks(q), to_chunks(k), to_chunks(v)))
    o = o.swapaxes(0, 1).reshape(B, nc * RET_CHUNK, RET_HEADS, RET_DV)
    return jnp.concatenate([o_meta, o], axis=1), state


def mla_attend(q_lat, q_pe, segments):
    qf = q_lat.astype(jnp.float32)
    pf = q_pe.astype(jnp.float32)
    scores = []
    for c_kv, k_pe, mask in segments:
        s = (jnp.einsum('bqhc,bkc->bhqk', qf, c_kv.astype(jnp.float32))
             + jnp.einsum('bqhr,bkr->bhqk', pf, k_pe.astype(jnp.float32))) * SOFTMAX_SCALE
        scores.append(jnp.where(mask, s, -jnp.inf))
    p = jax.nn.softmax(jnp.concatenate(scores, axis=-1), axis=-1)
    out = 0.0
    start = 0
    for c_kv, _, _ in segments:
        n = c_kv.shape[1]
        out = out + jnp.einsum('bhqk,bkc->bqhc', p[..., start:start + n], c_kv.astype(jnp.float32))
        start += n
    return out


def mla_prompt(q_lat, q_pe, c_kv, k_pe):
    B, T = q_lat.shape[0], q_lat.shape[1]
    mpos = jnp.arange(N_META)
    out_meta = mla_attend(q_lat[:, :N_META], q_pe[:, :N_META],
                          ((c_kv[:, :N_META], k_pe[:, :N_META], mpos[None, :] <= mpos[:, None]),))
    nb = (T - N_META) // ATTN_BLOCK
    kpos = jnp.arange(T)
    qb = q_lat[:, N_META:].reshape(B, nb, ATTN_BLOCK, MLA_HEADS, KV_LORA).swapaxes(0, 1)
    pb = q_pe[:, N_META:].reshape(B, nb, ATTN_BLOCK, MLA_HEADS, QK_ROPE).swapaxes(0, 1)
    starts = N_META + jnp.arange(nb) * ATTN_BLOCK

    def block(args):
        ql, qp, s0 = args
        qpos = s0 + jnp.arange(ATTN_BLOCK)
        return mla_attend(ql, qp, ((c_kv, k_pe, kpos[None, :] <= qpos[:, None]),))

    out = lax.map(block, (qb, pb, starts))
    out = out.swapaxes(0, 1).reshape(B, nb * ATTN_BLOCK, MLA_HEADS, KV_LORA)
    return jnp.concatenate([out_meta, out], axis=1)


def mixer_output(o_r, g_r, o_lat, w_uv, w_out):
    B, T = g_r.shape[0], g_r.shape[1]
    of = o_r.astype(jnp.float32)
    of = of * lax.rsqrt(jnp.mean(of * of, axis=-1, keepdims=True) + EPS)
    ret = of.reshape(B, T, RET_W) * jax.nn.silu(g_r.astype(jnp.float32))
    mla = jnp.einsum('bthc,chv->bthv', o_lat, w_uv.astype(jnp.float32)).reshape(B, T, MLA_W)
    return jnp.concatenate([ret, mla], axis=-1).astype(w_out.dtype) @ w_out


def conv_ffn(h, buf, w_up, conv_w, conv_b, w_down):
    u = h @ w_up
    T = u.shape[1]
    up = jnp.concatenate([buf.astype(u.dtype), u], axis=1)
    c = conv_b
    for j in range(CONV_W):
        c = c + conv_w[j] * up[:, j:j + T]
    a, g = jnp.split(c, 2, axis=-1)
    y = (jax.nn.silu(g) * a) @ w_down
    return y, up[:, up.shape[1] - (CONV_W - 1):]


def setup_inputs(seed: int = 0) -> dict:
    key = jax.random.key(seed)
    ks = jax.random.split(key, 24)
    n_pages = PAST_LEN // PAGE_SIZE
    n_used = DEC_BATCH * n_pages
    n_pool = n_used + n_used // 4

    def nrm(k, shape, scale=1.0):
        return jax.random.normal(k, shape, jnp.float32) * scale

    page_table = jax.random.permutation(ks[6], n_pool)[:n_used].reshape(DEC_BATCH, n_pages).astype(jnp.int32)
    return {
        'x_prompt': nrm(ks[0], (BATCH, SEQ, D_MODEL)),
        'x_sample': nrm(ks[1], (DEC_BATCH, DEC_SEQ, D_MODEL)),
        'cache_kv_latent': nrm(ks[2], (DEPTH, n_pool, PAGE_SIZE, KV_LORA)),
        'cache_k_rope': nrm(ks[3], (DEPTH, n_pool, PAGE_SIZE, QK_ROPE)),
        'state_retention': nrm(ks[4], (DEPTH, DEC_BATCH, RET_HEADS, RET_DK, RET_DV), 0.3),
        'state_ffn_conv': nrm(ks[5], (DEPTH, DEC_BATCH, CONV_W - 1, 2 * D_FF)),
        'page_table': page_table,
        'meta_tokens': nrm(ks[7], (N_META, D_MODEL)),
        'g_mix': 1.0 + nrm(ks[8], (DEPTH, D_MODEL), 0.01),
        'w_in': nrm(ks[9], (DEPTH, D_MODEL, IN_W), D_MODEL ** -0.5),
        'g_q': 1.0 + nrm(ks[10], (DEPTH, Q_LORA), 0.01),
        'w_uq': nrm(ks[11], (DEPTH, Q_LORA, MLA_HEADS * (QK_NOPE + QK_ROPE)), Q_LORA ** -0.5),
        'g_kv': 1.0 + nrm(ks[12], (DEPTH, KV_LORA), 0.01),
        'w_uk': nrm(ks[13], (DEPTH, KV_LORA, MLA_HEADS, QK_NOPE), KV_LORA ** -0.5),
        'w_uv': nrm(ks[14], (DEPTH, KV_LORA, MLA_HEADS, V_DIM), KV_LORA ** -0.5),
        'w_out': nrm(ks[15], (DEPTH, MIX_W, D_MODEL), MIX_W ** -0.5),
        'g_ffn': 1.0 + nrm(ks[16], (DEPTH, D_MODEL), 0.01),
        'w_up': nrm(ks[17], (DEPTH, D_MODEL, 2 * D_FF), D_MODEL ** -0.5),
        'conv_w': nrm(ks[18], (DEPTH, CONV_W, 2 * D_FF), CONV_W ** -0.5),
        'conv_b': nrm(ks[19], (DEPTH, 2 * D_FF), 0.01),
        'w_down': nrm(ks[20], (DEPTH, D_FF, D_MODEL), D_FF ** -0.5),
        'g_final': 1.0 + nrm(ks[21], (D_MODEL,), 0.01),
    }


def reference(x_prompt, x_sample, cache_kv_latent, cache_k_rope, state_retention, state_ffn_conv,
              page_table, meta_tokens, g_mix, w_in, g_q, w_uq, g_kv, w_uk, w_uv, w_out,
              g_ffn, w_up, conv_w, conv_b, w_down, g_final):
    B = x_prompt.shape[0]
    hp = jnp.concatenate([jnp.broadcast_to(meta_tokens.astype(x_prompt.dtype)[None], (B, N_META, D_MODEL)),
                          x_prompt], axis=1)
    Tp = hp.shape[1]
    pos_p = jnp.arange(Tp)
    hs = x_sample
    DB, Ls = hs.shape[0], hs.shape[1]
    past_len = page_table.shape[1] * PAGE_SIZE
    pos_s = past_len + jnp.arange(Ls)
    log_gamma = retention_log_decay()
    past_mask = jnp.ones((Ls, past_len), dtype=bool)
    self_mask = jnp.tril(jnp.ones((Ls, Ls), dtype=bool))

    kv_p, pe_p, ret_p, conv_p = [], [], [], []
    kv_s, pe_s, ret_s, conv_s = [], [], [], []
    for l in range(DEPTH):
        a = rmsnorm(hp, g_mix[l])
        q_r, k_r, v_r, g_r, q_lat, q_pe, c_kv, k_pe = mixer_inputs(a, pos_p, w_in[l], g_q[l], w_uq[l], g_kv[l], w_uk[l])
        o_r, st = retention_prompt(q_r, k_r, v_r, log_gamma)
        o_lat = mla_prompt(q_lat, q_pe, c_kv, k_pe)
        hp = hp + mixer_output(o_r, g_r, o_lat, w_uv[l], w_out[l])
        f, buf = conv_ffn(rmsnorm(hp, g_ffn[l]), jnp.zeros((B, CONV_W - 1, 2 * D_FF), hp.dtype),
                          w_up[l], conv_w[l], conv_b[l], w_down[l])
        hp = hp + f
        kv_p.append(c_kv)
        pe_p.append(k_pe)
        ret_p.append(st.astype(state_retention.dtype))
        conv_p.append(buf.astype(state_ffn_conv.dtype))

        a = rmsnorm(hs, g_mix[l])
        q_r, k_r, v_r, g_r, q_lat, q_pe, c_kv, k_pe = mixer_inputs(a, pos_s, w_in[l], g_q[l], w_uq[l], g_kv[l], w_uk[l])
        st, o_r = retention_chunk(state_retention[l].astype(jnp.float32), q_r, k_r, v_r, log_gamma)
        past_kv = cache_kv_latent[l][page_table].reshape(DB, past_len, KV_LORA)
        past_pe = cache_k_rope[l][page_table].reshape(DB, past_len, QK_ROPE)
        o_lat = mla_attend(q_lat, q_pe, ((past_kv, past_pe, past_mask), (c_kv, k_pe, self_mask)))
        hs = hs + mixer_output(o_r, g_r, o_lat, w_uv[l], w_out[l])
        f, buf = conv_ffn(rmsnorm(hs, g_ffn[l]), state_ffn_conv[l], w_up[l], conv_w[l], conv_b[l], w_down[l])
        hs = hs + f
        kv_s.append(c_kv)
        pe_s.append(k_pe)
        ret_s.append(st.astype(state_retention.dtype))
        conv_s.append(buf.astype(state_ffn_conv.dtype))

    y_prompt = rmsnorm(hp[:, N_META:], g_final)
    y_sample = rmsnorm(hs, g_final)
    return (y_prompt, y_sample,
            jnp.stack(kv_p), jnp.stack(pe_p), jnp.stack(ret_p), jnp.stack(conv_p),
            jnp.stack(kv_s), jnp.stack(pe_s), jnp.stack(ret_s), jnp.stack(conv_s))
```

```cpp
#include <hip/hip_runtime.h>
#include <stdint.h>

#ifndef PROBE_DUP
#define PROBE_DUP 0
#endif
#ifndef N_LAUNCH_PER_PHASE
#define N_LAUNCH_PER_PHASE 0
#endif

constexpr int DM = 1024, NB = 4, SEQ = 4096, NMETA = 16, TP = 4112, DB = 128, LS = 4, NPG = 64, PGSZ = 128;
constexpr int DFF = 2816, DFF2 = 5632;
constexpr int R_META = 16384, R_SAMP = 16640, MP = 17152;
constexpr int TPP = 4160;
constexpr int NSPLIT = 8;
constexpr float EPS = 1e-6f;
constexpr float QSCALE = 0.10411754627697264f;
constexpr float KSCALE = 0.08838834764831845f;
constexpr float FIX = 16777216.0f, IFIX = 1.0f / 16777216.0f;

constexpr size_t O_YP = 0, O_YS = 16777216, O_KVP = 17301504, O_KRP = 21512192, O_RETP = 22564864, O_CONVP = 22827008,
                 O_KVS = 22872064, O_KRS = 23003136, O_RETS = 23035904, O_CONVS = 31424512;

constexpr size_t al256(size_t x) { return (x + 255) & ~(size_t)255; }
constexpr size_t WS_CTL = 0;
constexpr size_t WS_SSQ = 65536;
constexpr size_t WS_ZERO_BYTES = WS_SSQ + 8 * (size_t)MP * 8;
constexpr size_t WS_A0 = al256(WS_ZERO_BYTES);
constexpr size_t WS_BTIN = WS_A0 + (size_t)MP * 1024 * 2;
constexpr size_t WS_BTUQ = WS_BTIN + (size_t)2816 * 1024 * 2;
constexpr size_t WS_BTSQ = WS_BTUQ + (size_t)768 * 384 * 2;
constexpr size_t WS_BTKV = WS_BTSQ + (size_t)1280 * 384 * 2;
constexpr size_t WS_BTOUT = WS_BTKV + (size_t)1024 * 256 * 2;
constexpr size_t WS_BTOUTS = WS_BTOUT + (size_t)1024 * 1024 * 2;
constexpr size_t WS_BTUP = WS_BTOUTS + (size_t)1024 * 1536 * 2;
constexpr size_t WS_BTDN = WS_BTUP + (size_t)5632 * 1024 * 2;
constexpr size_t WS_ROPE = WS_BTDN + (size_t)1024 * 2816 * 2;
constexpr size_t WS_QR = al256(WS_ROPE + (size_t)4116 * 192 * 4);
constexpr size_t WS_KR = WS_QR + (size_t)MP * 512 * 2;
constexpr size_t WS_VR = WS_KR + (size_t)MP * 512 * 2;
constexpr size_t WS_GR = WS_VR + (size_t)MP * 512 * 2;
constexpr size_t WS_KTD = WS_GR + (size_t)MP * 512 * 2;
constexpr size_t WS_VTR = WS_KTD + (size_t)16 * 128 * 4096 * 2;
constexpr size_t WS_CKVRAW = WS_VTR + (size_t)16 * 128 * 4096 * 2;
constexpr size_t WS_CKVB = WS_CKVRAW + (size_t)MP * 256 * 4;
constexpr size_t WS_CQB = WS_CKVB + (size_t)MP * 256 * 2;
constexpr size_t WS_KPE = WS_CQB + (size_t)MP * 384 * 2;
constexpr size_t WS_QP = WS_KPE + (size_t)4 * TPP * 64 * 2;
constexpr size_t WS_KP = WS_QP + (size_t)R_SAMP * 768 * 2;
constexpr size_t WS_VT = WS_KP + (size_t)4 * TPP * 512 * 2;
constexpr size_t WS_QSPE = WS_VT + (size_t)16 * 128 * TPP * 2;
constexpr size_t WS_QSLAT = WS_QSPE + (size_t)512 * 256 * 2;
constexpr size_t WS_U = WS_QSLAT + (size_t)512 * 1024 * 2;
constexpr size_t WS_SB = WS_U + (size_t)512 * 16384 * 4;
constexpr size_t WS_MIXA = WS_SB + (size_t)512 * 16384 * 2;
constexpr size_t WS_MIXS = WS_MIXA + (size_t)R_SAMP * 1024 * 2;
constexpr size_t WS_PARTO = WS_MIXS + (size_t)512 * 1536 * 2;
constexpr size_t WS_PARTML = WS_PARTO + (size_t)128 * NSPLIT * 16 * 256 * 4;
constexpr size_t WS_HP1 = al256(WS_PARTML + (size_t)128 * NSPLIT * 32 * 4);
constexpr size_t WS_HPB = WS_HP1 + (size_t)MP * 1024 * 4;
constexpr size_t WS_UFF = WS_HPB + (size_t)MP * 1024 * 2;
constexpr size_t WS_ACT = WS_UFF + (size_t)MP * 5632 * 2;
constexpr size_t WS_HP2 = WS_ACT + (size_t)MP * 2816 * 2;
constexpr size_t WS_END = WS_HP2 + (size_t)MP * 1024 * 4;

constexpr int LDS_BYTES = 163840;
constexpr int LDS_MISC = 162816;

typedef unsigned short bf16_t;
typedef short bf16x8 __attribute__((ext_vector_type(8)));
typedef short s16x4 __attribute__((ext_vector_type(4)));
typedef float f32x4 __attribute__((ext_vector_type(4)));
typedef float f32x2 __attribute__((ext_vector_type(2)));
typedef unsigned u32x4 __attribute__((ext_vector_type(4)));
typedef unsigned u32x2 __attribute__((ext_vector_type(2)));
#define LAS __attribute__((address_space(3)))

struct Params {
    const float* x_prompt; const float* x_sample; const float* cache_kv; const float* cache_pe; const float* state_ret; const float* state_conv;
    const int* page_table; const float* meta; const float* g_mix; const float* w_in; const float* g_q; const float* w_uq; const float* g_kv;
    const float* w_uk; const float* w_uv; const float* w_out; const float* g_ffn; const float* w_up; const float* conv_w; const float* conv_b;
    const float* w_down; const float* g_final;
    float* out; unsigned char* ws; int ph_lo, ph_hi;
};

__device__ __forceinline__ unsigned cvt_pk_bf16(float lo, float hi) { unsigned r; asm volatile("v_cvt_pk_bf16_f32 %0, %1, %2" : "=v"(r) : "v"(lo), "v"(hi)); return r; }
__device__ __forceinline__ bf16_t f2bf(float f) { unsigned u = __float_as_uint(f); u += 0x7FFFu + ((u >> 16) & 1u); return (bf16_t)(u >> 16); }
__device__ __forceinline__ float bf2f(bf16_t b) { return __uint_as_float(((unsigned)b) << 16); }
__device__ __forceinline__ float lg2g(int h) { return h == 0 ? -0.04580368961312479f : (h == 1 ? -0.02272007650008353f : (h == 2 ? -0.011315313227834146f : -0.005646563141142063f)); }
__device__ __forceinline__ int row_pidx(int r) { return r < R_META ? 16 + (r & 4095) : (r < R_SAMP ? (r - R_META) : 4112 + ((r - R_SAMP) & 3)); }
__device__ __forceinline__ float silu_f(float x) { return x * __builtin_amdgcn_rcpf(1.0f + __builtin_amdgcn_exp2f(-1.4426950408889634f * x)); }
__device__ __forceinline__ float rstd_of(const unsigned long long* ssq, int r, float inv_n) { return __builtin_amdgcn_rsqf((float)ssq[r] * IFIX * inv_n + EPS); }
__device__ __forceinline__ float wave_sum(float v) { for (int o = 32; o >= 1; o >>= 1) v += __shfl_xor(v, o); return v; }
__device__ __forceinline__ f32x4 mfma16(bf16x8 a, bf16x8 b, f32x4 c) { return __builtin_amdgcn_mfma_f32_16x16x32_bf16(a, b, c, 0, 0, 0); }

#define XB_TMO      128
#define XB_XCNT(j)  (256  + 64 * (j))
#define XB_XSUB(j)  (1280 + 64 * (j))
#define XB_XGEN(j)  (2304 + 64 * (j))
#define XB_TOP      3328
#define XB_TOPGEN   3392
#define XCD_BAR_WORDS 3456
#define XB_SPIN_CAP (1u << 18)
__device__ __forceinline__ unsigned xb_ld(unsigned* p)              { return __hip_atomic_load(p, __ATOMIC_RELAXED, __HIP_MEMORY_SCOPE_AGENT); }
__device__ __forceinline__ unsigned xb_add(unsigned* p, unsigned v) { return __hip_atomic_fetch_add(p, v, __ATOMIC_RELAXED, __HIP_MEMORY_SCOPE_AGENT); }
__device__ __forceinline__ unsigned xb_xcc_id() { return (unsigned)__builtin_amdgcn_s_getreg((3 << 11) | 20) & 0xFu; }
#define XB_SPIN(cond, bar) do { unsigned _sp = 0; while (cond) { __builtin_amdgcn_s_sleep(1); \
    if ((++_sp & 255u) == 0u) { if (xb_ld(&(bar)[XB_TMO])) break; if (_sp > XB_SPIN_CAP) { atomicAdd(&(bar)[XB_TMO], 1u); break; } } } } while (0)
struct XcdBarrier { unsigned* bar; unsigned x; volatile LAS unsigned* st; };
__device__ __forceinline__ XcdBarrier xcd_barrier_post(unsigned* bar, volatile LAS unsigned* st) {
    XcdBarrier b; b.bar = bar; b.x = xb_xcc_id(); b.st = st;
    if (threadIdx.x == 0) (void)xb_add(&bar[XB_XCNT(b.x)], 1u);
    return b;
}
__device__ __forceinline__ void xcd_barrier_complete(unsigned* bar, unsigned x, unsigned& nloc, unsigned& nx) {
    const unsigned G = gridDim.x * gridDim.y * gridDim.z;
    unsigned sum, cnt, mine, sp = 0u;
    for (;;) {
        sum = 0u; cnt = 0u; mine = 0u;
#pragma unroll
        for (unsigned j = 0; j < 16; ++j) { const unsigned c = xb_ld(&bar[XB_XCNT(j)]); sum += c; cnt += (c > 0u) ? 1u : 0u; mine = (j == x) ? c : mine; }
        if (sum == G) break;
        __builtin_amdgcn_s_sleep(1);
        if ((++sp & 255u) == 0u) { if (xb_ld(&bar[XB_TMO])) break; if (sp > XB_SPIN_CAP) { atomicAdd(&bar[XB_TMO], 1u); break; } }
    }
    nloc = mine > 0u ? mine : 1u; nx = cnt > 0u ? cnt : 1u;
}
__device__ __forceinline__ void xcd_barrier(const XcdBarrier& b) {
    asm volatile("s_waitcnt vmcnt(0)" ::: "memory");
    __syncthreads();
    if (threadIdx.x == 0) {
        unsigned* bar = b.bar;
        __builtin_amdgcn_s_waitcnt(0);
        unsigned nloc = b.st[0], nx = b.st[1];
        if (nloc == 0u) { xcd_barrier_complete(bar, b.x, nloc, nx); b.st[0] = nloc; b.st[1] = nx; }
        const unsigned old = xb_add(&bar[XB_XSUB(b.x)], 1u);
        const unsigned gen = old / nloc;
        if (old + 1u == (gen + 1u) * nloc) {
            __builtin_amdgcn_fence(__ATOMIC_RELEASE, "agent");
            asm volatile("s_waitcnt vmcnt(0)" ::: "memory");
            const unsigned og = xb_add(&bar[XB_TOP], 1u);
            const unsigned tg = og / nx;
            if (og + 1u == (tg + 1u) * nx) xb_add(&bar[XB_TOPGEN], 1u);
            else XB_SPIN(xb_ld(&bar[XB_TOPGEN]) == tg, bar);
            __builtin_amdgcn_fence(__ATOMIC_ACQUIRE, "agent");
            xb_add(&bar[XB_XGEN(b.x)], 1u);
            asm volatile("s_waitcnt vmcnt(0)" ::: "memory");
        } else {
            XB_SPIN(xb_ld(&bar[XB_XGEN(b.x)]) == gen, bar);
            __builtin_amdgcn_fence(__ATOMIC_ACQUIRE, "agent");
            asm volatile("s_waitcnt vmcnt(0)" ::: "memory");
        }
    }
    __syncthreads();
}

namespace pg8 {
#define PG8_LAS __attribute__((address_space(3)))
constexpr int BM = 256, BK = 64, HALF = 128, HTB = HALF * BK * 2, STAGE_BYTES = 8 * HTB, NXCD = 8, WGM = 8;
__host__ __device__ __forceinline__ int lds_byte(int r, int c) { const int st = (r >> 4) * 2 + (c >> 5), rr = r & 15, cc = c & 31, ob = rr * 64 + cc * 2; return st * 1024 + (ob ^ (((ob >> 9) & 1) << 5)); }
__host__ __device__ __forceinline__ void stage_rc(int b, int& R, int& C) { const int st = b / 1024, sb = b % 1024, swz = sb ^ (((sb >> 9) & 1) << 5); R = (st >> 1) * 16 + swz / 64; C = (st & 1) * 32 + (swz % 64) / 2; }
__host__ __device__ __forceinline__ int perm32(int rho) { const int n = rho >> 4, i = rho & 15; return 8 * (i >> 2) + 4 * n + (i & 3); }
struct Unit { int pm, pn; };
struct Gemm { const bf16_t* A; const bf16_t* Bt; int M, N, K; };
struct RowOrder {
    int nM, nN, nwg, G, c, pm0;
    __device__ __forceinline__ void init(int nM_, int nN_, int pm0_, int G_, int c_) { nM = nM_; nN = nN_; nwg = nM * nN; G = G_; c = c_; pm0 = pm0_; }
    __device__ __forceinline__ bool next(int i, Unit& u) const {
        const long L = (long)i * G + c; if (L >= nwg) return false;
        int wgid = (int)L; { const int q = nwg / NXCD, r = nwg % NXCD, xcd = wgid % NXCD, off = wgid / NXCD; wgid = (xcd < r ? xcd * (q + 1) : r * (q + 1) + (xcd - r) * q) + off; }
        const int nig = WGM * nN, gid = wgid / nig, fm = gid * WGM, gsz = (nM - fm) < WGM ? (nM - fm) : WGM;
        u.pm = pm0 + fm + ((wgid % nig) % gsz); u.pn = (wgid % nig) / gsz; return true;
    }
    __device__ __forceinline__ void a_ready(const Unit&) const {}
    __device__ __forceinline__ void done(const Unit&) const {}
};

template <class Epi, class Sched>
__device__ __forceinline__ void gemm_phase(PG8_LAS unsigned char* lds, const Gemm g, const Sched& S, const Epi& E) {
    int tid_ = threadIdx.x; asm volatile("" : "+v"(tid_));
    const int tid = tid_, wid = __builtin_amdgcn_readfirstlane(tid >> 6), lane = tid & 63, wr = wid >> 2, wc = wid & 3, fr = lane & 15, fq = lane >> 4;
    const int K = g.K, nt = K / BK;
    unsigned voffA[2], voffB[2];
#pragma unroll
    for (int i = 0; i < 2; ++i) { int R, C; stage_rc(tid * 16 + i * 8192, R, C); const int Rb = Epi::PERM ? ((R & ~31) + perm32(R & 31)) : R;
        voffA[i] = (unsigned)(R * K + C) * 2u; voffB[i] = (unsigned)(Rb * K + C) * 2u; }
    const size_t kstep = (size_t)(BK * 2);
    const size_t hstep = (size_t)HALF * K * 2;
    const size_t tstep = 2 * hstep;
    const unsigned ldsw = (unsigned)wid * 1024u;
    const int aoff = lds_byte(wr * 64 + fr, fq * 8), boff = lds_byte(wc * 32 + fr, fq * 8);
#define PG8_SA(b, h) (((b) * 2 + (h)) * HTB)
#define PG8_SB(b, h) ((4 + (b) * 2 + (h)) * HTB)
#define PG8_STAGE(bufoff, gbase, voff) do { _Pragma("unroll") for (int _i = 0; _i < 2; ++_i) \
        __builtin_amdgcn_global_load_lds((const unsigned*)((const char*)(gbase) + (voff)[_i]), (PG8_LAS unsigned*)(lds + (bufoff) + ldsw + _i * 8192), 16, 0, 0); } while (0)
#define PG8_LDA(dst, b, h) do { _Pragma("unroll") for (int m = 0; m < 4; ++m) _Pragma("unroll") for (int k = 0; k < 2; ++k) dst[m][k] = *(const PG8_LAS bf16x8*)(lds + PG8_SA(b, h) + aoff + m * 2048 + k * 1024); } while (0)
#define PG8_LDB(dst, b, h) do { _Pragma("unroll") for (int n = 0; n < 2; ++n) _Pragma("unroll") for (int k = 0; k < 2; ++k) dst[n][k] = *(const PG8_LAS bf16x8*)(lds + PG8_SB(b, h) + boff + n * 2048 + k * 1024); } while (0)
#define PG8_MMA(ai, bj, At, Bt) do { __builtin_amdgcn_s_setprio(1); _Pragma("unroll") for (int m = 0; m < 4; ++m) _Pragma("unroll") for (int n = 0; n < 2; ++n) _Pragma("unroll") for (int k = 0; k < 2; ++k) \
        acc[ai][bj][m][n] = __builtin_amdgcn_mfma_f32_16x16x32_bf16(Bt[n][k], At[m][k], acc[ai][bj][m][n], 0, 0, 0); __builtin_amdgcn_s_setprio(0); } while (0)
#define PG8_WAIT_V(n) asm volatile("s_waitcnt vmcnt(" #n ")" ::: "memory")
#define PG8_WAIT_L(n) asm volatile("s_waitcnt lgkmcnt(" #n ")" ::: "memory")
#define PG8_BAR __builtin_amdgcn_s_barrier()
#define PG8_SCHED __builtin_amdgcn_sched_barrier(0)
    Unit cur, nxt; int ui = 0;
    if (!S.next(0, cur)) return;
    f32x4 acc[2][2][4][2];
#pragma unroll
    for (int a = 0; a < 2; ++a)
#pragma unroll
        for (int b = 0; b < 2; ++b)
#pragma unroll
            for (int m = 0; m < 4; ++m)
#pragma unroll
                for (int n = 0; n < 2; ++n) acc[a][b][m][n] = (f32x4){0.f, 0.f, 0.f, 0.f};
    bf16x8 At[4][2], B0[2][2], B1[2][2];
    const char* cA = (const char*)g.A + (size_t)cur.pm * tstep; const char* cB = (const char*)g.Bt + (size_t)cur.pn * tstep;
    S.a_ready(cur);
    PG8_STAGE(PG8_SB(0, 0), cB, voffB); PG8_STAGE(PG8_SA(0, 0), cA, voffA); PG8_STAGE(PG8_SB(0, 1), cB + hstep, voffB); PG8_STAGE(PG8_SA(0, 1), cA + hstep, voffA);
    if (wr == 1) PG8_BAR;
    PG8_WAIT_V(4); PG8_BAR;
    PG8_STAGE(PG8_SB(1, 0), cB + kstep, voffB); PG8_STAGE(PG8_SA(1, 0), cA + kstep, voffA); PG8_STAGE(PG8_SB(1, 1), cB + hstep + kstep, voffB);
    PG8_WAIT_V(6); PG8_BAR;
    for (;;) {
        const bool has_next = S.next(ui + 1, nxt);
        const char* nA = has_next ? (const char*)g.A + (size_t)nxt.pm * tstep : cA; const char* nB = has_next ? (const char*)g.Bt + (size_t)nxt.pn * tstep : cB;
#pragma clang loop unroll(disable)
        for (int t = 0; t < nt; t += 2) {
            const bool last = (t == nt - 2);
            const char* a1 = cA + (size_t)(t + 1) * kstep;
            const char* a2 = last ? nA : cA + (size_t)(t + 2) * kstep; const char* b2 = last ? nB : cB + (size_t)(t + 2) * kstep;
            const char* a3 = a2 + kstep; const char* b3 = b2 + kstep;
            if (last && has_next) S.a_ready(nxt);
            PG8_LDB(B0, 0, 0); PG8_SCHED; PG8_LDA(At, 0, 0); PG8_STAGE(PG8_SA(1, 1), a1 + hstep, voffA);
            PG8_WAIT_L(8); PG8_BAR; PG8_WAIT_L(0); PG8_MMA(0, 0, At, B0); PG8_BAR; PG8_SCHED;
            PG8_LDB(B1, 0, 1); PG8_STAGE(PG8_SB(0, 0), b2, voffB);
            PG8_BAR; PG8_WAIT_L(0); PG8_MMA(0, 1, At, B1); PG8_BAR;
            PG8_LDA(At, 0, 1); PG8_STAGE(PG8_SA(0, 0), a2, voffA);
            PG8_BAR; PG8_WAIT_L(0); PG8_MMA(1, 0, At, B0); PG8_BAR; PG8_SCHED;
            PG8_STAGE(PG8_SB(0, 1), b2 + hstep, voffB);
            PG8_WAIT_V(6); PG8_BAR; PG8_MMA(1, 1, At, B1); PG8_BAR;
            PG8_LDB(B0, 1, 0); PG8_SCHED; PG8_LDA(At, 1, 0); PG8_STAGE(PG8_SA(0, 1), a2 + hstep, voffA);
            PG8_WAIT_L(8); PG8_BAR; PG8_WAIT_L(0); PG8_MMA(0, 0, At, B0); PG8_BAR; PG8_SCHED;
            PG8_LDB(B1, 1, 1); PG8_STAGE(PG8_SB(1, 0), b3, voffB);
            PG8_BAR; PG8_WAIT_L(0); PG8_MMA(0, 1, At, B1); PG8_BAR;
            PG8_LDA(At, 1, 1); PG8_STAGE(PG8_SA(1, 0), a3, voffA);
            PG8_BAR; PG8_WAIT_L(0); PG8_MMA(1, 0, At, B0); PG8_BAR; PG8_SCHED;
            PG8_STAGE(PG8_SB(1, 1), b3 + hstep, voffB);
            PG8_WAIT_V(6); PG8_BAR; PG8_MMA(1, 1, At, B1); PG8_BAR;
        }
        if constexpr (!Epi::AFTER_DRAIN) E(acc, cur, wr, wc, fr, fq);
        if (!has_next) break;
#pragma unroll
        for (int a = 0; a < 2; ++a)
#pragma unroll
            for (int b = 0; b < 2; ++b)
#pragma unroll
                for (int m = 0; m < 4; ++m)
#pragma unroll
                    for (int n = 0; n < 2; ++n) acc[a][b][m][n] = (f32x4){0.f, 0.f, 0.f, 0.f};
        cur = nxt; cA = nA; cB = nB; ++ui;
    }
    PG8_WAIT_V(0);
    if (wr == 0) PG8_BAR;
    PG8_BAR;
    if constexpr (Epi::AFTER_DRAIN) E(acc, cur, wr, wc, fr, fq);
#undef PG8_SA
#undef PG8_SB
#undef PG8_STAGE
#undef PG8_LDA
#undef PG8_LDB
#undef PG8_MMA
#undef PG8_WAIT_V
#undef PG8_WAIT_L
#undef PG8_BAR
#undef PG8_SCHED
}
}

enum { I_XP = 0, I_XS, I_CKV, I_CPE, I_SRET, I_SCONV, I_PT, I_META, I_GMIX, I_WIN, I_GQ, I_WUQ, I_GKV, I_WUK, I_WUV, I_WOUT, I_GFFN, I_WUP, I_CONVW, I_CONVB, I_WDOWN, I_GFINAL, I_NPTR };
struct Frame {
    LAS unsigned char* lds; int tid, lane, wave, G, bid, dup;
    unsigned char* ws; float* out;
    __device__ __forceinline__ const float* in(int i) const { const unsigned long long v = ((const LAS unsigned long long*)(lds + LDS_MISC + 64))[i];
        const unsigned lo = __builtin_amdgcn_readfirstlane((unsigned)v), hi = __builtin_amdgcn_readfirstlane((unsigned)(v >> 32));
        return (const float*)((const __attribute__((address_space(1))) float*)(((unsigned long long)hi << 32) | lo)); }
    __device__ __forceinline__ bf16_t* b16(size_t off) const { return (bf16_t*)(ws + off); }
    __device__ __forceinline__ float* f32(size_t off) const { return (float*)(ws + off); }
    __device__ __forceinline__ unsigned long long* ssq(int which) const { return (unsigned long long*)(ws + WS_SSQ) + (size_t)which * MP; }
    __device__ __forceinline__ unsigned long long* ssqw(int which) const { return (unsigned long long*)(ws + WS_SSQ) + (size_t)(which + 4 * dup) * MP; }
    __device__ __forceinline__ const float* rope(int which) const { const float* r = (const float*)(ws + WS_ROPE); return which == 0 ? r : (which == 1 ? r + 4116 * 64 : (which == 2 ? r + 4116 * 128 : r + 4116 * 160)); }
};
enum { SSQ_KV = 0, SSQ_Q = 1, SSQ_H = 2, SSQ_F = 3 };

__device__ __forceinline__ float wsrc(int job, int k, int n, const float* pa, const float* pb, const float* pc) {
    switch (job) {
    case 0: {
        int col;
        if (n < 1024) { const int seg = n >> 9, h = (n & 511) >> 7, j = n & 127, i = (j >> 1) + 64 * (j & 1); col = seg * 512 + h * 128 + i; }
        else if (n < 2048) col = n;
        else if (n < 2304) col = 2432 + (n - 2048);
        else if (n < 2560) col = 2048 + (n - 2304);
        else { const int q = n - 2560; if (q < 128) col = 2304 + q; else if (q < 192) { const int j = q - 128, i = (j >> 1) + 32 * (j & 1); col = 2688 + i; } else return 0.f; }
        return pa[(size_t)k * 2752 + col];
    }
    case 1: {
        int col;
        if (n < 512) col = (n >> 7) * 192 + (n & 127);
        else { const int h = (n - 512) >> 6, j = (n - 512) & 63, i = (j >> 1) + 32 * (j & 1); col = h * 192 + 128 + i; }
        return pa[(size_t)k * 768 + col] * pb[k];
    }
    case 2: {
        if (n < 256) { const int h = n >> 6, j = n & 63, i = (j >> 1) + 32 * (j & 1); return pa[(size_t)k * 768 + h * 192 + 128 + i] * pb[k]; }
        const int h = (n - 256) >> 8, c = (n - 256) & 255;
        const float* a = pa + (size_t)k * 768 + h * 192; const float* b = pc + (size_t)c * 512 + h * 128;
        float s = 0.f;
        for (int d = 0; d < 128; d += 4) { const f32x4 av = *(const f32x4*)(a + d), bv = *(const f32x4*)(b + d); s += av[0] * bv[0] + av[1] * bv[1] + av[2] * bv[2] + av[3] * bv[3]; }
        return s * pb[k];
    }
    case 3: {
        if (n < 512) return pa[(size_t)k * 512 + n] * pc[k];
        return pb[(size_t)k * 512 + (n - 512)] * pc[k];
    }
    case 4: return pa[(size_t)k * 1024 + n];
    case 5: {
        if (k < 512) return pa[(size_t)k * 1024 + n];
        const int h = (k - 512) >> 8, c = (k - 512) & 255;
        const float* a = pb + (size_t)c * 512 + h * 128; const float* b = pa + (size_t)(512 + h * 128) * 1024 + n;
        float s = 0.f;
        for (int v = 0; v < 128; ++v) s += a[v] * b[(size_t)v * 1024];
        return s;
    }
    case 6: { const int col = ((n >> 7) & 1) * 2816 + (n >> 8) * 128 + (n & 127); return pa[(size_t)k * 5632 + col] * pb[k]; }
    default: return pa[(size_t)k * 1024 + n];
    }
}

__device__ __forceinline__ void heavy_tile(const Frame& F, const float* A, int lda, const float* B, int ldbk, int ldbn, bf16_t* dst, int ldd, const float* scale) {
    const int w = F.wave, li = F.lane & 15, lk = F.lane >> 4, br = w >> 1, bc = (w & 1) * 2;
    f32x4 acc0 = (f32x4){0.f, 0.f, 0.f, 0.f}, acc1 = (f32x4){0.f, 0.f, 0.f, 0.f};
    const float* ap = A + (size_t)(16 * br + li) * lda + lk;
    const float* bp0 = B + (size_t)lk * ldbk + (size_t)(16 * bc + li) * ldbn; const float* bp1 = bp0 + (size_t)16 * ldbn;
#pragma unroll 8
    for (int v0 = 0; v0 < 128; v0 += 4) {
        const float a = ap[v0], b0 = bp0[(size_t)v0 * ldbk], b1 = bp1[(size_t)v0 * ldbk];
        acc0 = __builtin_amdgcn_mfma_f32_16x16x4f32(a, b0, acc0, 0, 0, 0); acc1 = __builtin_amdgcn_mfma_f32_16x16x4f32(a, b1, acc1, 0, 0, 0);
    }
    const int i0 = 16 * br + 4 * lk;
    f32x4 sc = (f32x4){1.f, 1.f, 1.f, 1.f};
    if (scale) sc = *(const f32x4*)(scale + i0);
    acc0 *= sc; acc1 *= sc;
    *(u32x2*)(dst + (size_t)(16 * bc + li) * ldd + i0) = (u32x2){cvt_pk_bf16(acc0[0], acc0[1]), cvt_pk_bf16(acc0[2], acc0[3])};
    *(u32x2*)(dst + (size_t)(16 * bc + 16 + li) * ldd + i0) = (u32x2){cvt_pk_bf16(acc1[0], acc1[1]), cvt_pk_bf16(acc1[2], acc1[3])};
}

__device__ __forceinline__ void phase_prologue(const Frame& F) {
    {
        LAS float* tile = (LAS float*)F.lds;
        int base = 0;
#define WTILE_NK(t_, N, K, NMAJ, n0, k0) const int n0 = (NMAJ) ? ((t_) / ((K) / 64)) * 64 : ((t_) % ((N) / 64)) * 64, k0 = (NMAJ) ? ((t_) % ((K) / 64)) * 64 : ((t_) / ((N) / 64)) * 64
#define WJOB_LIGHT(job, N, K, off, ia, ib, ic, NMAJ, T0, T1) do { const float* pa = F.in(ia); const float* pb = F.in(ib); const float* pc = F.in(ic); bf16_t* dst = F.b16(off); const int cnt = (T1) - (T0); const int first = (F.bid - base % F.G + F.G) % F.G; \
            _Pragma("unroll 1") for (int t = first; t < cnt; t += 4 * F.G) { float v_[4][8]; \
                _Pragma("unroll") for (int q = 0; q < 4; ++q) { const int tq = t + q * F.G; if (tq < cnt) { WTILE_NK((T0) + tq, N, K, NMAJ, n0, k0); \
                    _Pragma("unroll") for (int i = 0; i < 8; ++i) { const int idx = F.tid + 512 * i, kk = idx >> 6, nn = idx & 63; v_[q][i] = wsrc(job, k0 + kk, n0 + nn, pa, pb, pc); } } } \
                _Pragma("unroll") for (int q = 0; q < 4; ++q) { const int tq = t + q * F.G; if (tq < cnt) { \
                    _Pragma("unroll") for (int i = 0; i < 8; ++i) { const int idx = F.tid + 512 * i, kk = idx >> 6, nn = idx & 63; tile[q * 4160 + kk * 65 + nn] = v_[q][i]; } } } \
                __syncthreads(); \
                _Pragma("unroll") for (int q = 0; q < 4; ++q) { const int tq = t + q * F.G; if (tq < cnt) { WTILE_NK((T0) + tq, N, K, NMAJ, n0, k0); \
                    _Pragma("unroll") for (int i = 0; i < 8; ++i) { const int idx = F.tid + 512 * i, nn = idx >> 6, kk = idx & 63; dst[(size_t)(n0 + nn) * (K) + k0 + kk] = f2bf(tile[q * 4160 + kk * 65 + nn]); } } } \
                __syncthreads(); } \
            base += cnt; } while (0)
        {
            const float* w_out = F.in(I_WOUT); const float* w_uv = F.in(I_WUV); const float* w_uq = F.in(I_WUQ); const float* w_uk = F.in(I_WUK); const float* g_q = F.in(I_GQ);
#pragma unroll 1
            for (int t = F.bid; t < 352; t += F.G) {
                if (t < 256) { const int n0 = (t & 15) * 64, k0 = 512 + (t >> 4) * 64, h = (k0 - 512) >> 8, c0 = (k0 - 512) & 255;
                    heavy_tile(F, w_uv + (size_t)c0 * 512 + h * 128, 512, w_out + (size_t)(512 + h * 128) * 1024 + n0, 1024, 1, F.b16(WS_BTOUTS) + (size_t)n0 * 1536 + k0, 1536, nullptr); }
                else { const int u = t - 256, n0 = 256 + (u / 6) * 64, k0 = (u % 6) * 64, h = (n0 - 256) >> 8, c0 = (n0 - 256) & 255;
                    heavy_tile(F, w_uq + (size_t)k0 * 768 + h * 192, 768, w_uk + (size_t)c0 * 512 + h * 128, 1, 512, F.b16(WS_BTSQ) + (size_t)n0 * 384 + k0, 384, g_q + k0); }
            }
            base += 352;
        }
        WJOB_LIGHT(0, 2816, 1024, WS_BTIN, I_WIN, I_WIN, I_WIN, 0, 0, 704);
        WJOB_LIGHT(1, 768, 384, WS_BTUQ, I_WUQ, I_GQ, I_GQ, 0, 0, 72);
        WJOB_LIGHT(2, 1280, 384, WS_BTSQ, I_WUQ, I_GQ, I_WUK, 1, 0, 24);
        WJOB_LIGHT(3, 1024, 256, WS_BTKV, I_WUK, I_WUV, I_GKV, 0, 0, 64);
        WJOB_LIGHT(4, 1024, 1024, WS_BTOUT, I_WOUT, I_WOUT, I_WOUT, 0, 0, 256);
        WJOB_LIGHT(5, 1024, 1536, WS_BTOUTS, I_WOUT, I_WUV, I_WUV, 0, 0, 128);
        WJOB_LIGHT(6, 5632, 1024, WS_BTUP, I_WUP, I_GFFN, I_GFFN, 0, 0, 1408);
        WJOB_LIGHT(7, 1024, 2816, WS_BTDN, I_WDOWN, I_WDOWN, I_WDOWN, 0, 0, 704);
#undef WJOB_LIGHT
#undef WTILE_NK
    }
    {
        float* c128 = (float*)F.rope(0); float* s128 = (float*)F.rope(1); float* c64 = (float*)F.rope(2); float* s64 = (float*)F.rope(3);
        for (int idx = F.bid * 512 + F.tid; idx < 4116 * 96; idx += F.G * 512) {
            const int pi = idx / 96, f = idx % 96; const int pos = pi < 4112 ? pi : 8192 + (pi - 4112);
            const bool big = f < 64; const int fi = big ? f : f - 64;
            const double r = big ? 0.8659643233600653 : 0.7498942093324559;
            double iv = 1.0; for (int q = 0; q < fi; ++q) iv *= r;
            const float inv = (float)iv; const float angf = (float)pos * inv; const double ang = (double)angf;
            const double nq = __builtin_rint(ang * 0.6366197723675814);
            double x = __builtin_fma(-nq, 1.5707963267948966, ang); x = __builtin_fma(-nq, 6.123233995736766e-17, x);
            const double x2 = x * x;
            double sn = x * (1.0 + x2 * (-1.0 / 6 + x2 * (1.0 / 120 + x2 * (-1.0 / 5040 + x2 * (1.0 / 362880 + x2 * (-1.0 / 39916800 + x2 * (1.0 / 6227020800.0)))))));
            double cs = 1.0 + x2 * (-0.5 + x2 * (1.0 / 24 + x2 * (-1.0 / 720 + x2 * (1.0 / 40320 + x2 * (-1.0 / 3628800 + x2 * (1.0 / 479001600.0 + x2 * (-1.0 / 87178291200.0)))))));
            const int q4 = ((int)nq) & 3;
            double so, co;
            if (q4 == 0) { so = sn; co = cs; } else if (q4 == 1) { so = cs; co = -sn; } else if (q4 == 2) { so = -sn; co = -cs; } else { so = -cs; co = sn; }
            if (big) { c128[pi * 64 + fi] = (float)co; s128[pi * 64 + fi] = (float)so; } else { c64[pi * 32 + fi] = (float)co; s64[pi * 32 + fi] = (float)so; }
        }
    }
    {
        bf16_t* A0 = F.b16(WS_A0); const float* xp = F.in(I_XP); const float* xs = F.in(I_XS); const float* mt = F.in(I_META); const float* gmix = F.in(I_GMIX);
        f32x4 gg[4];
#pragma unroll
        for (int i = 0; i < 4; ++i) gg[i] = *(const f32x4*)(gmix + 4 * (F.lane + 64 * i));
#pragma unroll 1
        for (int r0 = F.bid * 8 + F.wave; r0 < MP; r0 += F.G * 32) {
            const float* src[4]; f32x4 v[4][4];
#pragma unroll
            for (int q = 0; q < 4; ++q) { const int r = r0 + q * F.G * 8; src[q] = nullptr;
                if (r < R_META) src[q] = xp + (size_t)r * 1024; else if (r < R_META + NMETA) src[q] = mt + (size_t)(r - R_META) * 1024; else if (r >= R_SAMP && r < MP) src[q] = xs + (size_t)(r - R_SAMP) * 1024;
                if (src[q]) {
#pragma unroll
                    for (int i = 0; i < 4; ++i) v[q][i] = *(const f32x4*)(src[q] + 4 * (F.lane + 64 * i)); } }
#pragma unroll
            for (int q = 0; q < 4; ++q) { const int r = r0 + q * F.G * 8; if (r >= MP) continue;
                u32x2* dst = (u32x2*)(A0 + (size_t)r * 1024);
                if (!src[q]) { for (int i = 0; i < 4; ++i) dst[F.lane + 64 * i] = (u32x2){0u, 0u}; continue; }
                float ss = 0.f;
#pragma unroll
                for (int i = 0; i < 4; ++i) ss += v[q][i][0] * v[q][i][0] + v[q][i][1] * v[q][i][1] + v[q][i][2] * v[q][i][2] + v[q][i][3] * v[q][i][3];
                ss = wave_sum(ss);
                const float rstd = __builtin_amdgcn_rsqf(ss * (1.0f / 1024.0f) + EPS);
#pragma unroll
                for (int i = 0; i < 4; ++i) { const f32x4 o = v[q][i] * rstd * gg[i];
                    dst[F.lane + 64 * i] = (u32x2){cvt_pk_bf16(o[0], o[1]), cvt_pk_bf16(o[2], o[3])}; } }
        }
    }
}

__device__ __forceinline__ void ssq_add(unsigned long long* ssq, int r, float ss, int fq) {
    ss += __shfl_xor(ss, 16); ss += __shfl_xor(ss, 32);
    if (fq == 0) atomicAdd(ssq + r, (unsigned long long)(ss * FIX));
}

__device__ __forceinline__ void quad_tr_store(const f32x4 a, bf16_t* col0, size_t stride, int lane) {
    const unsigned P = cvt_pk_bf16(a[0], a[1]), Q = cvt_pk_bf16(a[2], a[3]);
    const unsigned rP = (unsigned)__builtin_amdgcn_mov_dpp((int)P, 0xB1, 0xF, 0xF, false), rQ = (unsigned)__builtin_amdgcn_mov_dpp((int)Q, 0xB1, 0xF, 0xF, false);
    const unsigned sel = (lane & 1) ? 0x03020706u : 0x05040100u;
    const unsigned W0 = __builtin_amdgcn_perm(rP, P, sel), W1 = __builtin_amdgcn_perm(rQ, Q, sel);
    const bool up = (lane & 2) != 0;
    const unsigned rv = (unsigned)__builtin_amdgcn_mov_dpp((int)(up ? W0 : W1), 0x4E, 0xF, 0xF, false);
    *(u32x2*)(col0 + (size_t)(lane & 3) * stride) = (u32x2){up ? rv : W0, up ? W1 : rv};
}
struct EpiIn {
    static constexpr bool PERM = true, AFTER_DRAIN = false;
    Frame F;
    __device__ __forceinline__ void operator()(const f32x4 (&acc)[2][2][4][2], const pg8::Unit& u, int wr, int wc, int fr, int fq) const {
        const int pn = u.pn, pm = u.pm, rb = pm * 256 + wr * 64 + fr, cl = wc * 32 + 8 * fq;
        if (pn < 4) {
            const bool isk = pn >= 2; const int i0 = cl >> 1;
            bf16_t* dstb = F.b16(isk ? WS_KR : WS_QR); bf16_t* ktd = F.b16(WS_KTD);
            const float* C = F.rope(0); const float* S = F.rope(1);
            f32x4 ncs, nsn; { const int pi0 = row_pidx(rb); ncs = *(const f32x4*)(C + pi0 * 64 + i0); nsn = *(const f32x4*)(S + pi0 * 64 + i0); }
#pragma unroll
            for (int ai = 0; ai < 2; ++ai)
#pragma unroll
                for (int m = 0; m < 4; ++m) {
                    const int r = rb + ai * 128 + m * 16;
                    const f32x4 cs = ncs, sn = nsn;
                    if (ai * 4 + m < 7) { const int pi2 = row_pidx(rb + ((ai * 4 + m + 1) >> 2) * 128 + ((ai * 4 + m + 1) & 3) * 16); ncs = *(const f32x4*)(C + pi2 * 64 + i0); nsn = *(const f32x4*)(S + pi2 * 64 + i0); }
#pragma unroll
                    for (int bj = 0; bj < 2; ++bj) {
                        const int head = 2 * (pn & 1) + bj; const f32x4 v0 = acc[ai][bj][m][0], v1 = acc[ai][bj][m][1];
                        const f32x4 x1 = (f32x4){v0[0], v0[2], v1[0], v1[2]}, x2 = (f32x4){v0[1], v0[3], v1[1], v1[3]};
                        f32x4 o1 = x1 * cs - x2 * sn, o2 = x1 * sn + x2 * cs;
                        if (isk) { o1 *= KSCALE; o2 *= KSCALE; }
                        bf16_t* d = dstb + (size_t)r * 512 + head * 128;
                        *(u32x2*)(d + i0) = (u32x2){cvt_pk_bf16(o1[0], o1[1]), cvt_pk_bf16(o1[2], o1[3])};
                        *(u32x2*)(d + 64 + i0) = (u32x2){cvt_pk_bf16(o2[0], o2[1]), cvt_pk_bf16(o2[2], o2[3])};
                        if (isk && pm < 64) {
                            const int b = r >> 12, t = r & 4095; const float dec = __builtin_amdgcn_exp2f((float)(127 - (t & 127)) * lg2g(head));
                            bf16_t* kb = ktd + ((size_t)(b * 4 + head) * 128) * 4096 + (t & ~3);
                            quad_tr_store(o1 * dec, kb + (size_t)i0 * 4096, 4096, fr); quad_tr_store(o2 * dec, kb + (size_t)(64 + i0) * 4096, 4096, fr);
                        }
                    }
                }
        } else if (pn < 6) {
            bf16_t* vr = F.b16(WS_VR); bf16_t* vtr = F.b16(WS_VTR);
#pragma unroll
            for (int ai = 0; ai < 2; ++ai)
#pragma unroll
                for (int m = 0; m < 4; ++m) {
                    const int r = rb + ai * 128 + m * 16;
#pragma unroll
                    for (int bj = 0; bj < 2; ++bj) {
                        const int head = 2 * (pn - 4) + bj; const f32x4 v0 = acc[ai][bj][m][0], v1 = acc[ai][bj][m][1];
                        if (pm >= 64) *(u32x4*)(vr + (size_t)r * 512 + head * 128 + cl) = (u32x4){cvt_pk_bf16(v0[0], v0[1]), cvt_pk_bf16(v0[2], v0[3]), cvt_pk_bf16(v1[0], v1[1]), cvt_pk_bf16(v1[2], v1[3])};
                        else {
                            const int b = r >> 12, t = r & 4095; bf16_t* vb = vtr + ((size_t)(b * 4 + head) * 128 + cl) * 4096 + (t & ~3);
                            quad_tr_store(v0, vb, 4096, fr); quad_tr_store(v1, vb + (size_t)4 * 4096, 4096, fr);
                        }
                    }
                }
        } else if (pn < 8) {
            bf16_t* gr = F.b16(WS_GR);
#pragma unroll
            for (int ai = 0; ai < 2; ++ai)
#pragma unroll
                for (int m = 0; m < 4; ++m) {
                    const int r = rb + ai * 128 + m * 16;
#pragma unroll
                    for (int bj = 0; bj < 2; ++bj) {
                        const f32x4 v0 = acc[ai][bj][m][0], v1 = acc[ai][bj][m][1];
                        *(u32x4*)(gr + (size_t)r * 512 + (pn - 6) * 256 + bj * 128 + cl) = (u32x4){cvt_pk_bf16(silu_f(v0[0]), silu_f(v0[1])), cvt_pk_bf16(silu_f(v0[2]), silu_f(v0[3])),
                                                                                                  cvt_pk_bf16(silu_f(v1[0]), silu_f(v1[1])), cvt_pk_bf16(silu_f(v1[2]), silu_f(v1[3]))};
                    }
                }
        } else if (pn == 8) {
            bf16_t* cb = F.b16(WS_CKVB); unsigned long long* sq = F.ssqw(SSQ_KV);
#pragma unroll
            for (int ai = 0; ai < 2; ++ai)
#pragma unroll
                for (int m = 0; m < 4; ++m) {
                    const int r = rb + ai * 128 + m * 16; float ss = 0.f;
#pragma unroll
                    for (int bj = 0; bj < 2; ++bj) {
                        const f32x4 v0 = acc[ai][bj][m][0], v1 = acc[ai][bj][m][1]; const int col = bj * 128 + cl;
                        *(u32x4*)(cb + (size_t)r * 256 + col) = (u32x4){cvt_pk_bf16(v0[0], v0[1]), cvt_pk_bf16(v0[2], v0[3]), cvt_pk_bf16(v1[0], v1[1]), cvt_pk_bf16(v1[2], v1[3])};
                        ss += v0[0] * v0[0] + v0[1] * v0[1] + v0[2] * v0[2] + v0[3] * v0[3] + v1[0] * v1[0] + v1[1] * v1[1] + v1[2] * v1[2] + v1[3] * v1[3];
                    }
                    ssq_add(sq, r, ss, fq);
                }
        } else {
            bf16_t* cq = F.b16(WS_CQB); unsigned long long* sq = F.ssqw(SSQ_Q);
            const float* C = F.rope(2); const float* S = F.rope(3);
#pragma unroll
            for (int ai = 0; ai < 2; ++ai)
#pragma unroll
                for (int m = 0; m < 4; ++m) {
                    const int r = rb + ai * 128 + m * 16; float ss = 0.f;
#pragma unroll
                    for (int bj = 0; bj < 2; ++bj) {
                        const f32x4 v0 = acc[ai][bj][m][0], v1 = acc[ai][bj][m][1];
                        if (pn == 9 || bj == 0) {
                            const int col = (pn == 9 ? bj * 128 : 256) + cl;
                            *(u32x4*)(cq + (size_t)r * 384 + col) = (u32x4){cvt_pk_bf16(v0[0], v0[1]), cvt_pk_bf16(v0[2], v0[3]), cvt_pk_bf16(v1[0], v1[1]), cvt_pk_bf16(v1[2], v1[3])};
                            ss += v0[0] * v0[0] + v0[1] * v0[1] + v0[2] * v0[2] + v0[3] * v0[3] + v1[0] * v1[0] + v1[1] * v1[1] + v1[2] * v1[2] + v1[3] * v1[3];
                        } else if (wc < 2) {
                            const int i0 = cl >> 1, pi = row_pidx(r);
                            const f32x4 cs = *(const f32x4*)(C + pi * 32 + i0), sn = *(const f32x4*)(S + pi * 32 + i0);
                            const f32x4 x1 = (f32x4){v0[0], v0[2], v1[0], v1[2]}, x2 = (f32x4){v0[1], v0[3], v1[1], v1[3]};
                            const f32x4 o1 = x1 * cs - x2 * sn, o2 = x1 * sn + x2 * cs;
                            const u32x2 p1 = (u32x2){cvt_pk_bf16(o1[0], o1[1]), cvt_pk_bf16(o1[2], o1[3])}, p2 = (u32x2){cvt_pk_bf16(o2[0], o2[1]), cvt_pk_bf16(o2[2], o2[3])};
                            bf16_t* kpe = F.b16(WS_KPE);
                            if (pm < 64) {
                                const int b = r >> 12, pos = 16 + (r & 4095);
                                float* o = F.out + O_KRP + ((size_t)b * TP + pos) * 64; *(f32x4*)(o + i0) = o1; *(f32x4*)(o + 32 + i0) = o2;
                                bf16_t* kb = kpe + ((size_t)b * TPP + pos) * 64; *(u32x2*)(kb + i0) = p1; *(u32x2*)(kb + 32 + i0) = p2;
                            } else if (pm == 64) {
                                const int mm = r - R_META;
                                if (mm < NMETA) {
                                    float* o = F.out + O_KRP + (size_t)mm * 64; *(f32x4*)(o + i0) = o1; *(f32x4*)(o + 32 + i0) = o2;
                                    bf16_t* kb = kpe + (size_t)mm * 64; *(u32x2*)(kb + i0) = p1; *(u32x2*)(kb + 32 + i0) = p2;
                                }
                            } else {
                                float* o = F.out + O_KRS + (size_t)(r - R_SAMP) * 64; *(f32x4*)(o + i0) = o1; *(f32x4*)(o + 32 + i0) = o2;
                            }
                        }
                    }
                    ssq_add(sq, r, ss, fq);
                }
        }
    }
};

struct EpiUq {
    static constexpr bool PERM = true, AFTER_DRAIN = false;
    Frame F;
    __device__ __forceinline__ void operator()(const f32x4 (&acc)[2][2][4][2], const pg8::Unit& u, int wr, int wc, int fr, int fq) const {
        const int pn = u.pn, rb = u.pm * 256 + wr * 64 + fr, cl = wc * 32 + 8 * fq;
        bf16_t* qp = F.b16(WS_QP); const unsigned long long* sq = F.ssq(SSQ_Q);
        const float* C = F.rope(2); const float* S = F.rope(3);
        const int i0r = ((wc & 1) * 32 + 8 * fq) >> 1;
        unsigned long long nq = sq[rb]; f32x4 ncs = (f32x4){0.f, 0.f, 0.f, 0.f}, nsn = ncs;
        if (pn == 2) { const int pi0 = row_pidx(rb); ncs = *(const f32x4*)(C + pi0 * 32 + i0r); nsn = *(const f32x4*)(S + pi0 * 32 + i0r); }
#pragma unroll
        for (int ai = 0; ai < 2; ++ai)
#pragma unroll
            for (int m = 0; m < 4; ++m) {
                const int r = rb + ai * 128 + m * 16; const float sc = __builtin_amdgcn_rsqf((float)nq * IFIX * (1.0f / 384.0f) + EPS) * QSCALE;
                const f32x4 csr = ncs, snr = nsn;
                if (ai * 4 + m < 7) { const int r2 = rb + ((ai * 4 + m + 1) >> 2) * 128 + ((ai * 4 + m + 1) & 3) * 16; nq = sq[r2];
                    if (pn == 2) { const int pi2 = row_pidx(r2); ncs = *(const f32x4*)(C + pi2 * 32 + i0r); nsn = *(const f32x4*)(S + pi2 * 32 + i0r); } }
#pragma unroll
                for (int bj = 0; bj < 2; ++bj) {
                    const f32x4 v0 = acc[ai][bj][m][0] * sc, v1 = acc[ai][bj][m][1] * sc;
                    if (pn < 2) {
                        const int head = 2 * pn + bj;
                        *(u32x4*)(qp + ((size_t)r * 4 + head) * 192 + cl) = (u32x4){cvt_pk_bf16(v0[0], v0[1]), cvt_pk_bf16(v0[2], v0[3]), cvt_pk_bf16(v1[0], v1[1]), cvt_pk_bf16(v1[2], v1[3])};
                    } else {
                        const int head = 2 * bj + (wc >> 1), i0 = i0r;
                        const f32x4 cs = csr, sn = snr;
                        const f32x4 x1 = (f32x4){v0[0], v0[2], v1[0], v1[2]}, x2 = (f32x4){v0[1], v0[3], v1[1], v1[3]};
                        const f32x4 o1 = x1 * cs - x2 * sn, o2 = x1 * sn + x2 * cs;
                        bf16_t* d = qp + ((size_t)r * 4 + head) * 192 + 128;
                        *(u32x2*)(d + i0) = (u32x2){cvt_pk_bf16(o1[0], o1[1]), cvt_pk_bf16(o1[2], o1[3])};
                        *(u32x2*)(d + 32 + i0) = (u32x2){cvt_pk_bf16(o2[0], o2[1]), cvt_pk_bf16(o2[2], o2[3])};
                    }
                }
                asm volatile("" ::: "memory");
            }
    }
};

struct EpiSq {
    static constexpr bool PERM = true, AFTER_DRAIN = false;
    Frame F;
    __device__ __forceinline__ void operator()(const f32x4 (&acc)[2][2][4][2], const pg8::Unit& u, int wr, int wc, int fr, int fq) const {
        const int pn = u.pn, rb = u.pm * 256 + wr * 64 + fr, cl = wc * 32 + 8 * fq;
        bf16_t* qpe = F.b16(WS_QSPE); bf16_t* qlat = F.b16(WS_QSLAT); const unsigned long long* sq = F.ssq(SSQ_Q);
        const float* C = F.rope(2); const float* S = F.rope(3);
#pragma unroll
        for (int ai = 0; ai < 2; ++ai)
#pragma unroll
            for (int m = 0; m < 4; ++m) {
                const int r = rb + ai * 128 + m * 16, s = r - R_SAMP; const float sc = rstd_of(sq, r, 1.0f / 384.0f) * QSCALE;
#pragma unroll
                for (int bj = 0; bj < 2; ++bj) {
                    const f32x4 v0 = acc[ai][bj][m][0] * sc, v1 = acc[ai][bj][m][1] * sc;
                    if (pn == 0) {
                        const int head = 2 * bj + (wc >> 1), i0 = ((wc & 1) * 32 + 8 * fq) >> 1, pi = row_pidx(r);
                        const f32x4 cs = *(const f32x4*)(C + pi * 32 + i0), sn = *(const f32x4*)(S + pi * 32 + i0);
                        const f32x4 x1 = (f32x4){v0[0], v0[2], v1[0], v1[2]}, x2 = (f32x4){v0[1], v0[3], v1[1], v1[3]};
                        const f32x4 o1 = x1 * cs - x2 * sn, o2 = x1 * sn + x2 * cs;
                        bf16_t* d = qpe + ((size_t)s * 4 + head) * 64;
                        *(u32x2*)(d + i0) = (u32x2){cvt_pk_bf16(o1[0], o1[1]), cvt_pk_bf16(o1[2], o1[3])};
                        *(u32x2*)(d + 32 + i0) = (u32x2){cvt_pk_bf16(o2[0], o2[1]), cvt_pk_bf16(o2[2], o2[3])};
                    } else {
                        *(u32x4*)(qlat + ((size_t)s * 4 + (pn - 1)) * 256 + bj * 128 + cl) = (u32x4){cvt_pk_bf16(v0[0], v0[1]), cvt_pk_bf16(v0[2], v0[3]), cvt_pk_bf16(v1[0], v1[1]), cvt_pk_bf16(v1[2], v1[3])};
                    }
                }
                asm volatile("" ::: "memory");
            }
    }
};

struct EpiKv {
    static constexpr bool PERM = true, AFTER_DRAIN = false;
    Frame F;
    __device__ __forceinline__ void operator()(const f32x4 (&acc)[2][2][4][2], const pg8::Unit& u, int wr, int wc, int fr, int fq) const {
        const int pn = u.pn, pm = u.pm, rb = pm * 256 + wr * 64 + fr, cl = wc * 32 + 8 * fq;
        bf16_t* kp = F.b16(WS_KP); bf16_t* vt = F.b16(WS_VT); const unsigned long long* sq = F.ssq(SSQ_KV);
        unsigned long long nq = sq[rb];
#pragma unroll
        for (int ai = 0; ai < 2; ++ai)
#pragma unroll
            for (int m = 0; m < 4; ++m) {
                const int r = rb + ai * 128 + m * 16; const float sc = __builtin_amdgcn_rsqf((float)nq * IFIX * (1.0f / 256.0f) + EPS);
                if (ai * 4 + m < 7) nq = sq[rb + ((ai * 4 + m + 1) >> 2) * 128 + ((ai * 4 + m + 1) & 3) * 16];
                const bool ismeta = pm == 64; const int b = ismeta ? 0 : (r >> 12), pos = ismeta ? (r - R_META) : 16 + (r & 4095);
                if (ismeta && pos >= NMETA) continue;
#pragma unroll
                for (int bj = 0; bj < 2; ++bj) {
                    const f32x4 v0 = acc[ai][bj][m][0] * sc, v1 = acc[ai][bj][m][1] * sc;
                    if (pn < 2) {
                        const int head = 2 * pn + bj;
                        *(u32x4*)(kp + (((size_t)b * TPP + pos) * 4 + head) * 128 + cl) = (u32x4){cvt_pk_bf16(v0[0], v0[1]), cvt_pk_bf16(v0[2], v0[3]), cvt_pk_bf16(v1[0], v1[1]), cvt_pk_bf16(v1[2], v1[3])};
                    } else {
                        const int head = 2 * (pn - 2) + bj; bf16_t* vb = vt + ((size_t)(b * 4 + head) * 128 + cl) * TPP + (pos & ~3);
                        quad_tr_store(v0, vb, TPP, fr); quad_tr_store(v1, vb + (size_t)4 * TPP, TPP, fr);
                    }
                }
            }
    }
};

struct EpiOut {
    static constexpr bool PERM = true, AFTER_DRAIN = false;
    Frame F;
    __device__ __forceinline__ void operator()(f32x4 (&acc)[2][2][4][2], const pg8::Unit& u, int wr, int wc, int fr, int fq) const {
        const int pm = u.pm, rb = pm * 256 + wr * 64 + fr, c0 = u.pn * 256 + wc * 32 + 8 * fq;
        bf16_t* hpb = F.b16(WS_HPB); unsigned long long* sq = F.ssqw(SSQ_H);
        const float* xb = F.in(I_XP);
        f32x4 nx[2][2];
#pragma unroll
        for (int bj = 0; bj < 2; ++bj)
#pragma unroll
            for (int n = 0; n < 2; ++n) nx[bj][n] = *(const f32x4*)(xb + (unsigned)(rb * 1024 + c0 + bj * 128 + n * 4));
#pragma unroll
        for (int ai = 0; ai < 2; ++ai)
#pragma unroll
            for (int m = 0; m < 4; ++m) {
                const int r = rb + ai * 128 + m * 16; float ss = 0.f;
                f32x4 cur[2][2];
#pragma unroll
                for (int bj = 0; bj < 2; ++bj)
#pragma unroll
                    for (int n = 0; n < 2; ++n) cur[bj][n] = nx[bj][n];
                if (ai * 4 + m < 7) { const int r2 = rb + ((ai * 4 + m + 1) >> 2) * 128 + ((ai * 4 + m + 1) & 3) * 16;
#pragma unroll
                    for (int bj = 0; bj < 2; ++bj)
#pragma unroll
                        for (int n = 0; n < 2; ++n) nx[bj][n] = *(const f32x4*)(xb + (unsigned)(r2 * 1024 + c0 + bj * 128 + n * 4)); }
#pragma unroll
                for (int bj = 0; bj < 2; ++bj) {
                    const f32x4 o0 = cur[bj][0] + acc[ai][bj][m][0], o1 = cur[bj][1] + acc[ai][bj][m][1];
                    *(u32x4*)(hpb + (unsigned)(r * 1024 + c0 + bj * 128)) = (u32x4){cvt_pk_bf16(o0[0], o0[1]), cvt_pk_bf16(o0[2], o0[3]), cvt_pk_bf16(o1[0], o1[1]), cvt_pk_bf16(o1[2], o1[3])};
                    ss += o0[0] * o0[0] + o0[1] * o0[1] + o0[2] * o0[2] + o0[3] * o0[3] + o1[0] * o1[0] + o1[1] * o1[1] + o1[2] * o1[2] + o1[3] * o1[3];
                }
                ssq_add(sq, r, ss, fq);
            }
    }
};

__device__ __forceinline__ f32x4 ld_bf4(const bf16_t* p) { const u32x2 t = *(const u32x2*)p; return (f32x4){__uint_as_float(t[0] << 16), __uint_as_float(t[0] & 0xffff0000u), __uint_as_float(t[1] << 16), __uint_as_float(t[1] & 0xffff0000u)}; }
__device__ __forceinline__ float dpp_ror1(float v) { return __builtin_bit_cast(float, __builtin_amdgcn_mov_dpp(__builtin_bit_cast(int, v), 0x121, 0xF, 0xF, false)); }
__device__ __forceinline__ float dpp_ror2(float v) { return __builtin_bit_cast(float, __builtin_amdgcn_mov_dpp(__builtin_bit_cast(int, v), 0x122, 0xF, 0xF, false)); }
struct EpiUp {
    static constexpr bool PERM = true, AFTER_DRAIN = false;
    Frame F;
    __device__ __forceinline__ void operator()(f32x4 (&acc)[2][2][4][2], const pg8::Unit& u, int wr, int wc, int fr, int fq) const {
        const int pm = u.pm, rb = pm * 256 + wr * 64 + fr, ca = u.pn * 128 + wc * 32 + 8 * fq;
        bf16_t* uff = F.b16(WS_UFF); bf16_t* act = F.b16(WS_ACT); const unsigned long long* sq = F.ssq(SSQ_H);
#pragma unroll
        for (int ai = 0; ai < 2; ++ai)
#pragma unroll
            for (int m = 0; m < 4; ++m) { const float sc = rstd_of(sq, rb + ai * 128 + m * 16, 1.0f / 1024.0f);
#pragma unroll
                for (int bj = 0; bj < 2; ++bj) { acc[ai][bj][m][0] *= sc; acc[ai][bj][m][1] *= sc; } }
        const bool samp = pm >= 65;
#pragma unroll
        for (int ai = 0; ai < 2; ++ai)
#pragma unroll
            for (int m = 0; m < 4; ++m) {
                const int r = rb + ai * 128 + m * 16; float* st = nullptr; bool raw;
                if (pm < 64) { const int t = r & 4095; if (t >= 4094) st = F.out + O_CONVP + ((size_t)(r >> 12) * 2 + (t - 4094)) * 5632; raw = (m == 0 && fr < 2) || (m == 3 && fr >= 14); }
                else if (samp) { const int s_ = r - R_SAMP, l = s_ & 3; if (l >= 2) st = F.out + O_CONVS + ((size_t)(s_ >> 2) * 2 + (l - 2)) * 5632; raw = false; }
                else raw = true;
                if (raw || st) {
#pragma unroll
                    for (int bj = 0; bj < 2; ++bj) { const f32x4 v0 = acc[ai][bj][m][0], v1 = acc[ai][bj][m][1]; const int c = bj * 2816 + ca;
                        if (raw) *(u32x4*)(uff + (size_t)r * 5632 + c) = (u32x4){cvt_pk_bf16(v0[0], v0[1]), cvt_pk_bf16(v0[2], v0[3]), cvt_pk_bf16(v1[0], v1[1]), cvt_pk_bf16(v1[2], v1[3])};
                        if (st) { *(f32x4*)(st + c) = v0; *(f32x4*)(st + c + 4) = v1; } }
                }
            }
        if (pm == 64) return;
        const float* cw = F.in(I_CONVW); const float* cbp = F.in(I_CONVB);
        u32x2 keep[2][4];
        if (!samp) {
#pragma unroll
            for (int n = 0; n < 2; ++n) {
                const int col = ca + 4 * n;
                constexpr float NL2E = -1.4426950408889634f, NIL2E = -0.6931471805599453f;
                const f32x4 w0a = *(const f32x4*)(cw + col) * NIL2E, w1a = *(const f32x4*)(cw + 5632 + col) * NIL2E, w2a = *(const f32x4*)(cw + 11264 + col) * NIL2E, ba = *(const f32x4*)(cbp + col) * NIL2E;
                const f32x4 w0g = *(const f32x4*)(cw + 2816 + col) * NL2E, w1g = *(const f32x4*)(cw + 5632 + 2816 + col) * NL2E, w2g = *(const f32x4*)(cw + 11264 + 2816 + col) * NL2E, bg = *(const f32x4*)(cbp + 2816 + col) * NL2E;
#pragma unroll
                for (int ai = 0; ai < 2; ++ai) {
                    f32x4 p1a = (f32x4){0.f, 0.f, 0.f, 0.f}, p2a = p1a, p1g = p1a, p2g = p1a;
#pragma unroll
                    for (int m = 0; m < 4; ++m) {
                        const int r = rb + ai * 128 + m * 16;
                        const f32x4 xa = acc[ai][0][m][n], xg = acc[ai][1][m][n];
                        f32x4 r1a, r2a, r1g, r2g;
#pragma unroll
                        for (int j = 0; j < 4; ++j) { r1a[j] = dpp_ror1(xa[j]); r2a[j] = dpp_ror2(xa[j]); r1g[j] = dpp_ror1(xg[j]); r2g[j] = dpp_ror2(xg[j]); }
                        const f32x4 u1a = fr >= 1 ? r1a : p1a, u2a = fr >= 2 ? r2a : p2a, u1g = fr >= 1 ? r1g : p1g, u2g = fr >= 2 ? r2g : p2g;
                        const f32x4 cva = ba + w0a * u2a + w1a * u1a + w2a * xa, cvg = bg + w0g * u2g + w1g * u1g + w2g * xg;
                        f32x4 gv;
#pragma unroll
                        for (int j = 0; j < 4; ++j) gv[j] = cvg[j] * cva[j] * __builtin_amdgcn_rcpf(1.0f + __builtin_amdgcn_exp2f(cvg[j]));
                        const u32x2 res = (u32x2){cvt_pk_bf16(gv[0], gv[1]), cvt_pk_bf16(gv[2], gv[3])};
                        if (n == 0) keep[ai][m] = res;
                        else if (!(m == 0 && fr < 2)) *(u32x4*)(act + (size_t)r * DFF + ca) = (u32x4){keep[ai][m][0], keep[ai][m][1], res[0], res[1]};
                        p1a = r1a; p2a = r2a; p1g = r1g; p2g = r2g;
                    }
                }
            }
            return;
        }
        const float* scv = F.in(I_SCONV); const int lrow = fr & 3;
#pragma unroll
        for (int n = 0; n < 2; ++n) {
            const int col = ca + 4 * n;
            const f32x4 w0a = *(const f32x4*)(cw + col), w1a = *(const f32x4*)(cw + 5632 + col), w2a = *(const f32x4*)(cw + 11264 + col), ba = *(const f32x4*)(cbp + col);
            const f32x4 w0g = *(const f32x4*)(cw + 2816 + col), w1g = *(const f32x4*)(cw + 5632 + 2816 + col), w2g = *(const f32x4*)(cw + 11264 + 2816 + col), bg = *(const f32x4*)(cbp + 2816 + col);
#pragma unroll
            for (int ai = 0; ai < 2; ++ai)
#pragma unroll
                for (int m = 0; m < 4; ++m) {
                    const int r = rb + ai * 128 + m * 16;
                    const f32x4 xa = acc[ai][0][m][n], xg = acc[ai][1][m][n];
                    f32x4 u1a, u2a, u1g, u2g;
#pragma unroll
                    for (int j = 0; j < 4; ++j) { u1a[j] = dpp_ror1(xa[j]); u2a[j] = dpp_ror2(xa[j]); u1g[j] = dpp_ror1(xg[j]); u2g[j] = dpp_ror2(xg[j]); }
                    if (lrow < 2) { const float* s1 = scv + ((size_t)((r - R_SAMP) >> 2) * 2 + 1) * 5632 + col; const f32x4 s1a = *(const f32x4*)s1, s1g = *(const f32x4*)(s1 + 2816);
                        if (lrow == 0) { u1a = s1a; u1g = s1g; u2a = *(const f32x4*)(s1 - 5632); u2g = *(const f32x4*)(s1 - 5632 + 2816); } else { u2a = s1a; u2g = s1g; } }
                    const f32x4 cva = ba + w0a * u2a + w1a * u1a + w2a * xa, cvg = bg + w0g * u2g + w1g * u1g + w2g * xg;
                    *(u32x2*)(act + (size_t)r * DFF + col) = (u32x2){cvt_pk_bf16(silu_f(cvg[0]) * cva[0], silu_f(cvg[1]) * cva[1]), cvt_pk_bf16(silu_f(cvg[2]) * cva[2], silu_f(cvg[3]) * cva[3])};
                }
        }
    }
};

struct EpiDownNorm {
    static constexpr bool PERM = false, AFTER_DRAIN = true;
    Frame F;
    __device__ __forceinline__ void operator()(f32x4 (&acc)[2][2][4][2], const pg8::Unit& u, int wr, int wc, int fr, int fq) const {
        const int pm = u.pm, rb = pm * 256 + wr * 64 + fr, c0 = u.pn * 256 + wc * 32 + 4 * fq;
        const bf16_t* hpb = F.b16(WS_HPB); unsigned long long* sq = F.ssq(SSQ_F);
        unsigned* cnt = (unsigned*)(F.ws + WS_CTL + 32768) + 64 * pm; unsigned* tmo = (unsigned*)(F.ws + WS_CTL) + XB_TMO;
        {
            f32x4 nx[2][2];
#pragma unroll
            for (int bj = 0; bj < 2; ++bj)
#pragma unroll
                for (int n = 0; n < 2; ++n) nx[bj][n] = ld_bf4(hpb + (unsigned)(rb * 1024 + c0 + bj * 128 + n * 16));
#pragma unroll
            for (int ai = 0; ai < 2; ++ai)
#pragma unroll
                for (int m = 0; m < 4; ++m) {
                    const int r = rb + ai * 128 + m * 16; float ss = 0.f;
#pragma unroll
                    for (int bj = 0; bj < 2; ++bj)
#pragma unroll
                        for (int n = 0; n < 2; ++n) { const f32x4 o = nx[bj][n] + acc[ai][bj][m][n]; acc[ai][bj][m][n] = o; ss += o[0] * o[0] + o[1] * o[1] + o[2] * o[2] + o[3] * o[3]; }
                    if (ai * 4 + m < 7) { const int r2 = rb + ((ai * 4 + m + 1) >> 2) * 128 + ((ai * 4 + m + 1) & 3) * 16;
#pragma unroll
                        for (int bj = 0; bj < 2; ++bj)
#pragma unroll
                            for (int n = 0; n < 2; ++n) nx[bj][n] = ld_bf4(hpb + (unsigned)(r2 * 1024 + c0 + bj * 128 + n * 16)); }
                    ssq_add(sq, r, ss, fq);
                }
        }
        asm volatile("s_waitcnt vmcnt(0)" ::: "memory");
        if ((threadIdx.x & 63) == 0) {
            __hip_atomic_fetch_add(cnt, 1u, __ATOMIC_RELAXED, __HIP_MEMORY_SCOPE_AGENT);
            unsigned sp = 0;
            while (__hip_atomic_load(cnt, __ATOMIC_RELAXED, __HIP_MEMORY_SCOPE_AGENT) < 32u) { __builtin_amdgcn_s_sleep(1); if (++sp > (1u << 22)) { __hip_atomic_store(tmo, 1u, __ATOMIC_RELAXED, __HIP_MEMORY_SCOPE_AGENT); break; } }
        }
        asm volatile("" ::: "memory");
        const float* gfin = F.in(I_GFINAL); float* y = F.out + O_YP;
        f32x4 gf[2][2];
#pragma unroll
        for (int bj = 0; bj < 2; ++bj)
#pragma unroll
            for (int n = 0; n < 2; ++n) gf[bj][n] = *(const f32x4*)(gfin + c0 + bj * 128 + n * 16);
#pragma unroll
        for (int ai = 0; ai < 2; ++ai)
#pragma unroll
            for (int m = 0; m < 4; ++m) {
                const int r = rb + ai * 128 + m * 16;
                const float rstd = __builtin_amdgcn_rsqf((float)__hip_atomic_load(sq + r, __ATOMIC_RELAXED, __HIP_MEMORY_SCOPE_AGENT) * IFIX * (1.0f / 1024.0f) + EPS);
#pragma unroll
                for (int bj = 0; bj < 2; ++bj)
#pragma unroll
                    for (int n = 0; n < 2; ++n) *(f32x4*)(y + (unsigned)(r * 1024 + c0 + bj * 128 + n * 16)) = acc[ai][bj][m][n] * rstd * gf[bj][n];
            }
    }
};

template <int NCB, class Epi> __device__ __forceinline__ void small_gemm_unit(const Frame& F, const bf16_t* A, const bf16_t* Bt, int K, int row0, int col0, const Epi& E) {
    const int lr = F.lane & 15, g = F.lane >> 4, w = F.wave, nks = K >> 8;
    f32x4 acc[2][NCB];
#pragma unroll
    for (int rb = 0; rb < 2; ++rb)
#pragma unroll
        for (int cb = 0; cb < NCB; ++cb) acc[rb][cb] = (f32x4){0.f, 0.f, 0.f, 0.f};
    const bf16_t* ap = A + (size_t)lr * K + (size_t)w * nks * 32 + 8 * g; const bf16_t* bp = Bt + (size_t)lr * K + (size_t)w * nks * 32 + 8 * g;
#pragma unroll 6
    for (int i = 0; i < nks; ++i) {
        const bf16x8 a0 = *(const bf16x8*)(ap + 32 * i), a1 = *(const bf16x8*)(ap + (size_t)16 * K + 32 * i);
#pragma unroll
        for (int cb = 0; cb < NCB; ++cb) { const bf16x8 bf = *(const bf16x8*)(bp + (size_t)(16 * cb) * K + 32 * i); acc[0][cb] = mfma16(bf, a0, acc[0][cb]); acc[1][cb] = mfma16(bf, a1, acc[1][cb]); }
    }
    LAS f32x4* P = (LAS f32x4*)F.lds;
#pragma unroll
    for (int rb = 0; rb < 2; ++rb)
#pragma unroll
        for (int cb = 0; cb < NCB; ++cb) P[((w * 2 + rb) * NCB + cb) * 64 + F.lane] = acc[rb][cb];
    __syncthreads();
    const int row = F.tid >> 4, cg = F.tid & 15;
    f32x4 v[NCB / 4];
#pragma unroll
    for (int q = 0; q < NCB / 4; ++q) {
        const int idx = (((row >> 4) * NCB + 4 * q + (cg >> 2)) * 64) + (cg & 3) * 16 + (row & 15);
        v[q] = P[idx];
#pragma unroll
        for (int ww = 1; ww < 8; ++ww) v[q] += P[ww * (2 * NCB * 64) + idx];
    }
    E.template run<NCB / 4>(F, row0 + row, col0 + 4 * cg, v, cg);
    __syncthreads();
}
__device__ __forceinline__ float row16_sum(float ss) { ss += __shfl_xor(ss, 1); ss += __shfl_xor(ss, 2); ss += __shfl_xor(ss, 4); ss += __shfl_xor(ss, 8); return ss; }
struct SEpiOut {
    const float* xb; bf16_t* hpb; unsigned long long* ssq; int rmax;
    template <int NQ> __device__ __forceinline__ void run(const Frame& F, int r, int c, const f32x4 (&v)[NQ], int cg) const {
        float ss = 0.f;
#pragma unroll
        for (int q = 0; q < NQ; ++q) { const int cc = c + 64 * q;
            const f32x4 o = *(const f32x4*)(xb + (size_t)(r < rmax ? r : rmax) * 1024 + cc) + v[q];
            *(u32x2*)(hpb + (size_t)r * 1024 + cc) = (u32x2){cvt_pk_bf16(o[0], o[1]), cvt_pk_bf16(o[2], o[3])};
            ss += o[0] * o[0] + o[1] * o[1] + o[2] * o[2] + o[3] * o[3]; }
        ss = row16_sum(ss);
        if (cg == 0) atomicAdd(ssq + r, (unsigned long long)(ss * FIX));
    }
};
struct SEpiDownNorm {
    const bf16_t* hpb; const float* g_final; float* y; unsigned long long* ssq; unsigned* cnt; unsigned* tmo;
    template <int NQ> __device__ __forceinline__ void run(const Frame& F, int r, int c, const f32x4 (&v)[NQ], int cg) const {
        const f32x4 o = ld_bf4(hpb + (size_t)r * 1024 + c) + v[0];
        float ss = row16_sum(o[0] * o[0] + o[1] * o[1] + o[2] * o[2] + o[3] * o[3]);
        if (cg == 0) atomicAdd(ssq + r, (unsigned long long)(ss * FIX));
        asm volatile("s_waitcnt vmcnt(0)" ::: "memory");
        __syncthreads();
        if (F.tid == 0) {
            __hip_atomic_fetch_add(cnt, 1u, __ATOMIC_RELAXED, __HIP_MEMORY_SCOPE_AGENT);
            unsigned sp = 0;
            while (__hip_atomic_load(cnt, __ATOMIC_RELAXED, __HIP_MEMORY_SCOPE_AGENT) < 16u) { __builtin_amdgcn_s_sleep(1); if (++sp > (1u << 22)) { __hip_atomic_store(tmo, 1u, __ATOMIC_RELAXED, __HIP_MEMORY_SCOPE_AGENT); break; } }
        }
        __syncthreads();
        const float rstd = __builtin_amdgcn_rsqf((float)__hip_atomic_load(ssq + r, __ATOMIC_RELAXED, __HIP_MEMORY_SCOPE_AGENT) * IFIX * (1.0f / 1024.0f) + EPS);
        *(f32x4*)(y + (size_t)(r - R_SAMP) * 1024 + c) = o * rstd * *(const f32x4*)(g_final + c);
    }
};

__device__ __forceinline__ void task_kvlat(const Frame& F) {
    const bf16_t* raw = F.b16(WS_CKVB); const unsigned long long* sq = F.ssq(SSQ_KV); float* out = F.out;
    const f32x4 g = *(const f32x4*)(F.in(I_GKV) + 4 * F.lane);
    constexpr int NR = R_META + NMETA + 512;
    for (int i0 = F.bid * 8 + F.wave; i0 < NR; i0 += F.G * 32) {
        f32x4 v[4]; int rr[4];
#pragma unroll
        for (int q = 0; q < 4; ++q) { const int i = i0 + q * F.G * 8; rr[q] = i < R_META + NMETA ? i : R_SAMP + (i - (R_META + NMETA));
            if (i < NR) v[q] = ld_bf4(raw + (size_t)rr[q] * 256 + 4 * F.lane) * rstd_of(sq, rr[q], 1.0f / 256.0f) * g; }
#pragma unroll
        for (int q = 0; q < 4; ++q) { const int i = i0 + q * F.G * 8, r = rr[q]; if (i >= NR) continue;
            if (r < R_META) *(f32x4*)(out + O_KVP + ((size_t)(r >> 12) * TP + 16 + (r & 4095)) * 256 + 4 * F.lane) = v[q];
            else if (r < R_SAMP) { for (int b = 0; b < 4; ++b) *(f32x4*)(out + O_KVP + ((size_t)b * TP + (r - R_META)) * 256 + 4 * F.lane) = v[q]; }
            else *(f32x4*)(out + O_KVS + (size_t)(r - R_SAMP) * 256 + 4 * F.lane) = v[q]; }
    }
    for (int idx = F.bid * 512 + F.tid; idx < 3 * NMETA * 64; idx += F.G * 512) {
        const int b = 1 + idx / (NMETA * 64), e = idx % (NMETA * 64); out[O_KRP + (size_t)b * TP * 64 + e] = out[O_KRP + e]; }
}
__device__ __forceinline__ void task_uc(const Frame& F) {
    const bf16_t* vtr = F.b16(WS_VTR); const bf16_t* ktd = F.b16(WS_KTD); float* U = F.f32(WS_U);
    const int lr = F.lane & 15, g = F.lane >> 4;
    for (int it = F.bid; it < 512; it += F.G) {
        const int bh = it >> 5, c = it & 31, t0 = c * 128;
        bf16x8 af[4];
#pragma unroll
        for (int ks = 0; ks < 4; ++ks) af[ks] = *(const bf16x8*)(vtr + ((size_t)bh * 128 + 16 * F.wave + lr) * 4096 + t0 + 32 * ks + 8 * g);
#pragma unroll 2
        for (int db = 0; db < 8; ++db) {
            f32x4 a = (f32x4){0.f, 0.f, 0.f, 0.f};
#pragma unroll
            for (int ks = 0; ks < 4; ++ks) { const bf16x8 bf = *(const bf16x8*)(ktd + ((size_t)bh * 128 + 16 * db + lr) * 4096 + t0 + 32 * ks + 8 * g); a = mfma16(af[ks], bf, a); }
            float* o = U + ((size_t)it * 128 + 16 * F.wave + 4 * g) * 128 + 16 * db + lr;
#pragma unroll
            for (int j = 0; j < 4; ++j) o[(size_t)j * 128] = a[j];
        }
    }
}

constexpr int RS_V = 0, RS_K = 4096, RS_BUF = 36864;
__device__ __forceinline__ void retscan_item(const Frame& F_, int it) {
    Frame F = F_; { int t_ = F_.tid; asm volatile("" : "+v"(t_)); F.tid = t_; F.lane = t_ & 63; }
    const int bh = it >> 3, dvb = it & 7, h = bh & 3, w = F.wave, lr = F.lane & 15, g = F.lane >> 4; const float lg = lg2g(h);
    f32x4 acc = (f32x4){0.f, 0.f, 0.f, 0.f};
    { const bf16_t* kr = F.b16(WS_KR) + (size_t)R_META * 512 + h * 128 + 16 * w + 4 * g; const bf16_t* vr = F.b16(WS_VR) + (size_t)R_META * 512 + h * 128 + 16 * dvb + lr;
#pragma unroll 4
      for (int m = 0; m < NMETA; ++m) { const u32x2 kk = *(const u32x2*)(kr + (size_t)m * 512); const float vv = bf2f(vr[(size_t)m * 512]) * __builtin_amdgcn_exp2f((float)(15 - m) * lg);
          acc[0] += vv * __uint_as_float(kk[0] << 16); acc[1] += vv * __uint_as_float(kk[0] & 0xffff0000u); acc[2] += vv * __uint_as_float(kk[1] << 16); acc[3] += vv * __uint_as_float(kk[1] & 0xffff0000u); } }
    const float g128 = __builtin_amdgcn_exp2f(128.0f * lg);
    unsigned so[5];
#pragma unroll
    for (int i = 0; i < 4; ++i) { const int row = 16 * w + 4 * i + (F.lane >> 4); so[i] = (unsigned)(row * 8192 + ((F.lane & 15) ^ (row & 15)) * 16); }
    { const int row = 4 * (w & 3) + (F.lane >> 4); so[4] = (unsigned)((16 * dvb + row) * 8192 + ((F.lane & 15) ^ (row & 15)) * 16); }
    const char* ksrc = (const char*)(F.b16(WS_KTD) + (size_t)bh * 128 * 4096); const char* vsrc = (const char*)(F.b16(WS_VTR) + (size_t)bh * 128 * 4096);
#define RS_DMA(c_, buf) do { LAS unsigned char* B_ = F.lds + (buf) * RS_BUF; const size_t cb_ = (size_t)(c_) * 256; \
        _Pragma("unroll") for (int i_ = 0; i_ < 4; ++i_) __builtin_amdgcn_global_load_lds((const unsigned*)(ksrc + cb_ + so[i_]), (LAS unsigned*)(B_ + RS_K + 1024 * (4 * w + i_)), 16, 0, 0); \
        __builtin_amdgcn_global_load_lds((const unsigned*)(vsrc + cb_ + so[4]), (LAS unsigned*)(B_ + RS_V + 1024 * (w & 3)), 16, 0, 0); } while (0)
    int koff[4];
#pragma unroll
    for (int ks = 0; ks < 4; ++ks) koff[ks] = lr * 256 + 16 * ((4 * ks + g) ^ lr);
    bf16_t* sbp = F.b16(WS_SB) + (size_t)bh * 32 * 16384 + (size_t)(16 * dvb + lr) * 128 + 16 * w + 4 * g;
    asm volatile("s_waitcnt vmcnt(0)" ::: "memory");
    RS_DMA(0, 0); RS_DMA(1, 1); RS_DMA(2, 2);
    asm volatile("s_waitcnt vmcnt(10)" ::: "memory");
    __builtin_amdgcn_s_barrier();
    int bcur = 0;
#pragma unroll 1
    for (int c = 0; c < 32; ++c) {
        if (c + 3 < 32) { RS_DMA(c + 3, (bcur + 3) & 3); }
        const LAS unsigned char* Bt = F.lds + bcur * RS_BUF;
        bf16x8 kf[4], vf[4];
#pragma unroll
        for (int ks = 0; ks < 4; ++ks) { kf[ks] = *(const LAS bf16x8*)(Bt + RS_K + w * 4096 + koff[ks]); vf[ks] = *(const LAS bf16x8*)(Bt + RS_V + koff[ks]); }
        __hip_atomic_store((unsigned long long*)(sbp + (size_t)c * 16384), ((unsigned long long)cvt_pk_bf16(acc[2], acc[3]) << 32) | cvt_pk_bf16(acc[0], acc[1]), __ATOMIC_RELAXED, __HIP_MEMORY_SCOPE_AGENT);
        acc *= g128;
#pragma unroll
        for (int ks = 0; ks < 4; ++ks) acc = mfma16(kf[ks], vf[ks], acc);
        if (c + 3 < 32) { if (c == 0) asm volatile("s_waitcnt vmcnt(11)" ::: "memory"); else asm volatile("s_waitcnt vmcnt(12)" ::: "memory"); } else if (c + 2 < 32) asm volatile("s_waitcnt vmcnt(6)" ::: "memory"); else asm volatile("s_waitcnt vmcnt(0)" ::: "memory");
        __builtin_amdgcn_s_barrier();
        bcur = (bcur + 1) & 3;
    }
#undef RS_DMA
    float* o = F.out + O_RETP + (size_t)bh * 16384 + (size_t)(16 * w + 4 * g) * 128 + 16 * dvb + lr;
#pragma unroll
    for (int j = 0; j < 4; ++j) o[(size_t)j * 128] = acc[j];
    asm volatile("s_waitcnt vmcnt(0)" ::: "memory");
    __syncthreads();
    if (F.tid == 64) __hip_atomic_fetch_add((unsigned*)(F.ws + WS_CTL + 20480) + 16 * bh, 1u, __ATOMIC_RELAXED, __HIP_MEMORY_SCOPE_AGENT);
    __syncthreads();
}

__device__ __forceinline__ void task_scan(const Frame& F) {
    const bf16_t* kr = F.b16(WS_KR); const bf16_t* vr = F.b16(WS_VR); const float* U = F.f32(WS_U); bf16_t* SB = F.b16(WS_SB);
    for (int it = F.bid; it < 256; it += F.G) {
        const int bh = it >> 4, sl = it & 15, h = bh & 3, b = bh >> 2;
        const int e0 = sl * 1024 + F.tid * 2, dv = e0 >> 7, dk = e0 & 127;
        const float lg = lg2g(h);
        float s0 = 0.f, s1 = 0.f;
        for (int m = 0; m < NMETA; ++m) {
            const float w = __builtin_amdgcn_exp2f((float)(15 - m) * lg);
            const float vv = bf2f(vr[(size_t)(R_META + m) * 512 + h * 128 + dv]) * w;
            s0 += vv * bf2f(kr[(size_t)(R_META + m) * 512 + h * 128 + dk]); s1 += vv * bf2f(kr[(size_t)(R_META + m) * 512 + h * 128 + dk + 1]);
        }
        const float g128 = __builtin_amdgcn_exp2f(128.0f * lg);
        f32x2 uu[32];
#pragma unroll
        for (int c = 0; c < 32; ++c) uu[c] = *(const f32x2*)(U + ((size_t)bh * 32 + c) * 16384 + e0);
#pragma unroll
        for (int c = 0; c < 32; ++c) {
            *(unsigned*)(SB + ((size_t)bh * 32 + c) * 16384 + e0) = cvt_pk_bf16(s0, s1);
            s0 = g128 * s0 + uu[c][0]; s1 = g128 * s1 + uu[c][1];
        }
        float* o = F.out + O_RETP + (size_t)bh * 16384;
        o[(size_t)dk * 128 + dv] = s0; o[(size_t)(dk + 1) * 128 + dv] = s1;
    }
}

__device__ __forceinline__ void meta_ret_item(const Frame& F, int h_item) {
    const bf16_t* qr = F.b16(WS_QR); const bf16_t* kr = F.b16(WS_KR); const bf16_t* vr = F.b16(WS_VR); const bf16_t* gr = F.b16(WS_GR); bf16_t* mixa = F.b16(WS_MIXA);
    LAS float* sc = (LAS float*)F.lds; LAS float* ob = sc + 256;
    { const int h = h_item;
        const float lg = lg2g(h);
        if (F.tid < 256) {
            const int m = F.tid >> 4, s = F.tid & 15; float d = 0.f;
            if (s <= m) { for (int k = 0; k < 128; ++k) d += bf2f(qr[(size_t)(R_META + m) * 512 + h * 128 + k]) * bf2f(kr[(size_t)(R_META + s) * 512 + h * 128 + k]); d *= __builtin_amdgcn_exp2f((float)(m - s) * lg); }
            sc[F.tid] = d;
        }
        __syncthreads();
        for (int i = 0; i < 4; ++i) {
            const int idx = F.tid + 512 * i, m = idx >> 7, dv = idx & 127; float o = 0.f;
            for (int s = 0; s <= m; ++s) o += sc[m * 16 + s] * bf2f(vr[(size_t)(R_META + s) * 512 + h * 128 + dv]);
            ob[idx] = o;
        }
        __syncthreads();
        for (int m = F.wave; m < 16; m += 8) {
            const float a = ob[m * 128 + F.lane], b2 = ob[m * 128 + 64 + F.lane];
            const float rstd = __builtin_amdgcn_rsqf(wave_sum(a * a + b2 * b2) * (1.0f / 128.0f) + EPS);
            const size_t ro = (size_t)(R_META + m);
            mixa[ro * 1024 + h * 128 + F.lane] = f2bf(a * rstd * bf2f(gr[ro * 512 + h * 128 + F.lane]));
            mixa[ro * 1024 + h * 128 + 64 + F.lane] = f2bf(b2 * rstd * bf2f(gr[ro * 512 + h * 128 + 64 + F.lane]));
        }
        __syncthreads();
    }
}

__device__ __forceinline__ void sample_ret_item(const Frame& F, int it) {
    const float* state_ret = F.in(I_SRET); const bf16_t* qr = F.b16(WS_QR); const bf16_t* kr = F.b16(WS_KR); const bf16_t* vr = F.b16(WS_VR); const bf16_t* gr = F.b16(WS_GR); bf16_t* mixs = F.b16(WS_MIXS);
    LAS float* q = (LAS float*)F.lds; LAS float* k = q + 512; LAS float* v = k + 512; LAS float* red = v + 512; LAS float* qk = red + 2048; LAS float* o2 = qk + 16;
    {
        const int b = it >> 2, h = it & 3; const float lg = lg2g(h);
        { const int l = F.tid >> 7, d = F.tid & 127; const size_t ro = (size_t)(R_SAMP + b * 4 + l) * 512 + h * 128 + d; q[F.tid] = bf2f(qr[ro]); k[F.tid] = bf2f(kr[ro]); v[F.tid] = bf2f(vr[ro]); }
        __syncthreads();
        const int dv = F.tid & 127, dq = F.tid >> 7;
        const float* st = state_ret + (size_t)it * 16384; float* so = F.out + O_RETS + (size_t)it * 16384;
        const float g4 = __builtin_amdgcn_exp2f(4.0f * lg), gp0 = __builtin_amdgcn_exp2f(3.0f * lg), gp1 = __builtin_amdgcn_exp2f(2.0f * lg), gp2 = __builtin_amdgcn_exp2f(lg);
        const float v0 = v[dv] * gp0, v1 = v[128 + dv] * gp1, v2 = v[256 + dv] * gp2, v3 = v[384 + dv];
        float c0 = 0.f, c1 = 0.f, c2 = 0.f, c3 = 0.f;
        float sv[32];
#pragma unroll
        for (int i = 0; i < 32; ++i) sv[i] = st[(size_t)(dq * 32 + i) * 128 + dv];
#pragma unroll
        for (int i = 0; i < 32; ++i) {
            const int dk = dq * 32 + i; const float s = sv[i];
            c0 += q[dk] * s; c1 += q[128 + dk] * s; c2 += q[256 + dk] * s; c3 += q[384 + dk] * s;
            so[(size_t)dk * 128 + dv] = g4 * s + k[dk] * v0 + k[128 + dk] * v1 + k[256 + dk] * v2 + k[384 + dk] * v3;
        }
        red[(dq * 4 + 0) * 128 + dv] = c0; red[(dq * 4 + 1) * 128 + dv] = c1; red[(dq * 4 + 2) * 128 + dv] = c2; red[(dq * 4 + 3) * 128 + dv] = c3;
#pragma unroll
        for (int pp = 0; pp < 2; ++pp) { const int p_ = 2 * F.wave + pp, l = p_ >> 2, m = p_ & 3;
            float d = wave_sum(q[l * 128 + F.lane] * k[m * 128 + F.lane] + q[l * 128 + 64 + F.lane] * k[m * 128 + 64 + F.lane]);
            if (F.lane == 0) qk[p_] = m <= l ? d * __builtin_amdgcn_exp2f((float)(l - m) * lg) : 0.f; }
        __syncthreads();
        { const int l = F.tid >> 7; float o = 0.f;
          for (int a = 0; a < 4; ++a) o += red[(a * 4 + l) * 128 + dv];
          o *= __builtin_amdgcn_exp2f((float)(l + 1) * lg);
          for (int m = 0; m <= l; ++m) o += qk[l * 4 + m] * v[m * 128 + dv];
          o2[F.tid] = o; }
        __syncthreads();
        if (F.wave < 4) {
            const int l = F.wave; const float a = o2[l * 128 + F.lane], b2 = o2[l * 128 + 64 + F.lane];
            const float rstd = __builtin_amdgcn_rsqf(wave_sum(a * a + b2 * b2) * (1.0f / 128.0f) + EPS);
            const size_t ro = (size_t)(R_SAMP + b * 4 + l), so2 = (size_t)(b * 4 + l);
            mixs[so2 * 1536 + h * 128 + F.lane] = f2bf(a * rstd * bf2f(gr[ro * 512 + h * 128 + F.lane]));
            mixs[so2 * 1536 + h * 128 + 64 + F.lane] = f2bf(b2 * rstd * bf2f(gr[ro * 512 + h * 128 + 64 + F.lane]));
        }
        __syncthreads();
    }
}

__device__ __forceinline__ void attn_wave(const Frame& F_, int b, int h, int qrow0, int qpos0) {
    Frame F = F_; { int t_ = F_.tid; asm volatile("" : "+v"(t_)); F.tid = t_; F.lane = t_ & 63; }
    const int lr = F.lane & 15, g = F.lane >> 4;
    const bf16_t* Q = F.b16(WS_QP) + ((size_t)qrow0 * 4 + h) * 192;
    bf16x8 qf[2][6];
#pragma unroll
    for (int qg = 0; qg < 2; ++qg)
#pragma unroll
        for (int ks = 0; ks < 6; ++ks) qf[qg][ks] = *(const bf16x8*)(Q + (size_t)(16 * qg + lr) * 768 + 32 * ks + 8 * g);
    f32x4 o[2][8];
#pragma unroll
    for (int qg = 0; qg < 2; ++qg)
#pragma unroll
        for (int d = 0; d < 8; ++d) o[qg][d] = (f32x4){0.f, 0.f, 0.f, 0.f};
    float mrun[2] = {-INFINITY, -INFINITY}, lrun[2] = {0.f, 0.f};
    const int qpos[2] = {qpos0 + lr, qpos0 + 16 + lr};
    const int nkb = (qpos0 + 31) / 32 + 1;
    const bf16_t* Kb0 = F.b16(WS_KP) + h * 128; const bf16_t* Kbb = Kb0 + (size_t)b * TPP * 512;
    const bf16_t* Eb0 = F.b16(WS_KPE); const bf16_t* Ebb = Eb0 + (size_t)b * TPP * 64;
    const bf16_t* Vb0 = F.b16(WS_VT) + (size_t)h * 128 * TPP; const bf16_t* Vbb = Vb0 + (size_t)b * 4 * 128 * TPP;
#pragma unroll 1
    for (int kb = 0; kb < nkb; ++kb) {
        const int k0 = 32 * kb;
        f32x4 s[2][2];
#pragma unroll
        for (int kg = 0; kg < 2; ++kg)
#pragma unroll
            for (int qg = 0; qg < 2; ++qg) s[kg][qg] = (f32x4){0.f, 0.f, 0.f, 0.f};
#pragma unroll
        for (int ks = 0; ks < 6; ++ks)
#pragma unroll
            for (int kg = 0; kg < 2; ++kg) {
                const bf16_t* Kb = (kb == 0 && kg == 0) ? Kb0 : Kbb; const bf16_t* Eb = (kb == 0 && kg == 0) ? Eb0 : Ebb;
                const bf16x8 kf = ks < 4 ? *(const bf16x8*)(Kb + (size_t)(k0 + 16 * kg + lr) * 512 + 32 * ks + 8 * g) : *(const bf16x8*)(Eb + (size_t)(k0 + 16 * kg + lr) * 64 + 32 * (ks - 4) + 8 * g);
#pragma unroll
                for (int qg = 0; qg < 2; ++qg) s[kg][qg] = mfma16(kf, qf[qg][ks], s[kg][qg]);
            }
        if (k0 + 31 > qpos0) {
#pragma unroll
            for (int kg = 0; kg < 2; ++kg)
#pragma unroll
                for (int qg = 0; qg < 2; ++qg)
#pragma unroll
                    for (int j = 0; j < 4; ++j) if (k0 + 16 * kg + 4 * g + j > qpos[qg]) s[kg][qg][j] = -INFINITY;
        }
        bf16x8 pf[2];
#pragma unroll
        for (int qg = 0; qg < 2; ++qg) {
            float mx = fmaxf(fmaxf(fmaxf(s[0][qg][0], s[0][qg][1]), fmaxf(s[0][qg][2], s[0][qg][3])), fmaxf(fmaxf(s[1][qg][0], s[1][qg][1]), fmaxf(s[1][qg][2], s[1][qg][3])));
            mx = fmaxf(mx, __shfl_xor(mx, 16)); mx = fmaxf(mx, __shfl_xor(mx, 32));
            const float mn = fmaxf(mrun[qg], mx), al = __builtin_amdgcn_exp2f(mrun[qg] - mn);
            float pv[8]; float rs = 0.f;
#pragma unroll
            for (int j = 0; j < 4; ++j) { pv[j] = __builtin_amdgcn_exp2f(s[0][qg][j] - mn); pv[4 + j] = __builtin_amdgcn_exp2f(s[1][qg][j] - mn); rs += pv[j] + pv[4 + j]; }
            rs += __shfl_xor(rs, 16); rs += __shfl_xor(rs, 32);
            lrun[qg] = lrun[qg] * al + rs; mrun[qg] = mn;
#pragma unroll
            for (int d = 0; d < 8; ++d) o[qg][d] *= al;
            u32x4 pk = (u32x4){cvt_pk_bf16(pv[0], pv[1]), cvt_pk_bf16(pv[2], pv[3]), cvt_pk_bf16(pv[4], pv[5]), cvt_pk_bf16(pv[6], pv[7])};
            pf[qg] = __builtin_bit_cast(bf16x8, pk);
        }
#pragma unroll
        for (int d = 0; d < 8; ++d) {
            const size_t vo = (size_t)(16 * d + lr) * TPP + k0 + 4 * g;
            const u32x2 lo = *(const u32x2*)((kb == 0 ? Vb0 : Vbb) + vo), hi = *(const u32x2*)(Vbb + vo + 16);
            const bf16x8 vf = __builtin_bit_cast(bf16x8, (u32x4){lo[0], lo[1], hi[0], hi[1]});
#pragma unroll
            for (int qg = 0; qg < 2; ++qg) o[qg][d] = mfma16(vf, pf[qg], o[qg][d]);
        }
    }
    bf16_t* mixa = F.b16(WS_MIXA);
#pragma unroll
    for (int qg = 0; qg < 2; ++qg) {
        const float il = 1.0f / lrun[qg]; bf16_t* d0 = mixa + (size_t)(qrow0 + 16 * qg + lr) * 1024 + 512 + h * 128 + 4 * g;
#pragma unroll
        for (int d = 0; d < 8; ++d) { const f32x4 v = o[qg][d] * il; *(u32x2*)(d0 + 16 * d) = (u32x2){cvt_pk_bf16(v[0], v[1]), cvt_pk_bf16(v[2], v[3])}; }
    }
}


constexpr int AT_KN = 0, AT_KR = 16384, AT_VT = 24576, AT_BUF = 40960;
__device__ __forceinline__ void attn_unit(const Frame& F_, int j) {
    Frame F = F_; { int t_ = F_.tid; asm volatile("" : "+v"(t_)); F.tid = t_; F.lane = t_ & 63; }
    const int bh = j & 15, b = bh >> 2, h = bh & 3, pp = j >> 4, lr = F.lane & 15, g = F.lane >> 4, w = F.wave;
    const int blk = (w >> 2) ? 31 - pp : pp, t0 = blk * 128 + 32 * (w & 3), qrow0 = b * 4096 + t0, qpos0 = 16 + t0;
    const int ntile = (143 + 128 * (31 - pp)) / 64 + 1;
    const char* K0 = (const char*)(F.b16(WS_KP) + h * 128); const char* Kb = K0 + (size_t)b * TPP * 1024;
    const char* E0 = (const char*)F.b16(WS_KPE); const char* Eb = E0 + (size_t)b * TPP * 128;
    const char* V0 = (const char*)(F.b16(WS_VT) + (size_t)h * 128 * TPP); const char* Vb = V0 + (size_t)b * 4 * 128 * TPP * 2;
    bf16x8 qf[2][6];
    { const bf16_t* Q = F.b16(WS_QP) + ((size_t)qrow0 * 4 + h) * 192;
#pragma unroll
      for (int qg = 0; qg < 2; ++qg)
#pragma unroll
          for (int ks = 0; ks < 6; ++ks) qf[qg][ks] = *(const bf16x8*)(Q + (size_t)(16 * qg + lr) * 768 + 32 * ks + 8 * g); }
    f32x4 o[2][8];
#pragma unroll
    for (int qg = 0; qg < 2; ++qg)
#pragma unroll
        for (int d = 0; d < 8; ++d) o[qg][d] = (f32x4){0.f, 0.f, 0.f, 0.f};
    float mrun[2] = {0.f, 0.f}, lrun[2] = {0.f, 0.f};
    const int qpos[2] = {qpos0 + lr, qpos0 + 16 + lr};
    unsigned so[5]; int srow[5];
#pragma unroll
    for (int i = 0; i < 2; ++i) { const int row = 4 * (2 * w + i) + (F.lane >> 4), c = (F.lane & 15) ^ (row & 15); so[i] = (unsigned)(row * 1024 + c * 16); srow[i] = row; }
    { const int row = 8 * w + (F.lane >> 3), c = (F.lane & 7) ^ ((row >> 1) & 7); so[2] = (unsigned)(row * 128 + c * 16); srow[2] = row; }
#pragma unroll
    for (int i = 0; i < 2; ++i) { const int row = 8 * (2 * w + i) + (F.lane >> 3), c = (F.lane & 7) ^ ((row >> 1) & 7); so[3 + i] = (unsigned)(row * (TPP * 2) + c * 16); srow[3 + i] = c * 8; }
    int koff[4], roff[2], voff[2][2];
#pragma unroll
    for (int ks = 0; ks < 4; ++ks) koff[ks] = AT_KN + lr * 256 + 16 * ((4 * ks + g) ^ lr);
#pragma unroll
    for (int k2 = 0; k2 < 2; ++k2) roff[k2] = AT_KR + lr * 128 + 16 * ((4 * k2 + g) ^ (lr >> 1));
#pragma unroll
    for (int sb = 0; sb < 2; ++sb)
#pragma unroll
        for (int hh = 0; hh < 2; ++hh) voff[sb][hh] = AT_VT + lr * 128 + 16 * ((4 * sb + (g >> 1) + 2 * hh) ^ (lr >> 1)) + 8 * (g & 1);
#define AT_DMA(t, buf) do { const int t_ = (t); LAS unsigned char* B_ = F.lds + (buf) * AT_BUF; const size_t kb_ = (size_t)t_ * 64; \
        _Pragma("unroll") for (int i_ = 0; i_ < 2; ++i_) __builtin_amdgcn_global_load_lds((const unsigned*)(((t_ == 0 && srow[i_] < 16) ? K0 : Kb) + kb_ * 1024 + so[i_]), (LAS unsigned*)(B_ + AT_KN + 1024 * (2 * w + i_)), 16, 0, 0); \
        __builtin_amdgcn_global_load_lds((const unsigned*)(((t_ == 0 && srow[2] < 16) ? E0 : Eb) + kb_ * 128 + so[2]), (LAS unsigned*)(B_ + AT_KR + 1024 * w), 16, 0, 0); \
        _Pragma("unroll") for (int i_ = 0; i_ < 2; ++i_) __builtin_amdgcn_global_load_lds((const unsigned*)(((t_ == 0 && srow[3 + i_] < 16) ? V0 : Vb) + kb_ * 2 + so[3 + i_]), (LAS unsigned*)(B_ + AT_VT + 1024 * (2 * w + i_)), 16, 0, 0); } while (0)
    asm volatile("s_waitcnt vmcnt(0)" ::: "memory");
    AT_DMA(0, 0);
    if (ntile > 1) { AT_DMA(1, 1); asm volatile("s_waitcnt vmcnt(5)" ::: "memory"); } else asm volatile("s_waitcnt vmcnt(0)" ::: "memory");
    __builtin_amdgcn_s_barrier();
    int bcur = 0;
#pragma unroll 1
    for (int t = 0; t < ntile; ++t) {
        if (t + 2 < ntile) { const int bn = bcur >= 1 ? bcur - 1 : 2; AT_DMA(t + 2, bn); }
        if (64 * t <= qpos0 + 31) {
            const LAS unsigned char* Bt = F.lds + bcur * AT_BUF;
#pragma unroll 1
            for (int sub = 0; sub < 2; ++sub) {
                const int k0 = 64 * t + 32 * sub;
                if (k0 > qpos0 + 31) break;
                const LAS unsigned char* Kt = Bt + sub * 32 * 256; const LAS unsigned char* Rt = Bt + sub * 32 * 128;
                bf16x8 kf[2][6];
#pragma unroll
                for (int kg = 0; kg < 2; ++kg) {
#pragma unroll
                    for (int ks = 0; ks < 4; ++ks) kf[kg][ks] = *(const LAS bf16x8*)(Kt + kg * 4096 + koff[ks]);
#pragma unroll
                    for (int k2 = 0; k2 < 2; ++k2) kf[kg][4 + k2] = *(const LAS bf16x8*)(Rt + kg * 2048 + roff[k2]);
                }
                f32x4 s[2][2];
#pragma unroll
                for (int kg = 0; kg < 2; ++kg) { s[kg][0] = (f32x4){-mrun[0], -mrun[0], -mrun[0], -mrun[0]}; s[kg][1] = (f32x4){-mrun[1], -mrun[1], -mrun[1], -mrun[1]}; }
                __builtin_amdgcn_sched_barrier(0);
                asm volatile("s_waitcnt lgkmcnt(0)" ::: "memory");
                __builtin_amdgcn_sched_barrier(0);
#pragma unroll
                for (int ks = 0; ks < 6; ++ks)
#pragma unroll
                    for (int kg = 0; kg < 2; ++kg) { s[kg][0] = mfma16(kf[kg][ks], qf[0][ks], s[kg][0]); s[kg][1] = mfma16(kf[kg][ks], qf[1][ks], s[kg][1]); }
                u32x2 vlo[8], vhi[8];
#pragma unroll
                for (int d = 0; d < 8; ++d) { vlo[d] = *(const LAS u32x2*)(Bt + d * 2048 + voff[sub][0]); vhi[d] = *(const LAS u32x2*)(Bt + d * 2048 + voff[sub][1]); }
                __builtin_amdgcn_sched_barrier(0);
                if (k0 + 31 > qpos0) {
#pragma unroll
                    for (int kg = 0; kg < 2; ++kg)
#pragma unroll
                        for (int qg = 0; qg < 2; ++qg)
#pragma unroll
                            for (int jj = 0; jj < 4; ++jj) if (k0 + 16 * kg + 4 * g + jj > qpos[qg]) s[kg][qg][jj] = -INFINITY;
                }
                float mx0 = fmaxf(fmaxf(fmaxf(s[0][0][0], s[0][0][1]), fmaxf(s[0][0][2], s[0][0][3])), fmaxf(fmaxf(s[1][0][0], s[1][0][1]), fmaxf(s[1][0][2], s[1][0][3])));
                float mx1 = fmaxf(fmaxf(fmaxf(s[0][1][0], s[0][1][1]), fmaxf(s[0][1][2], s[0][1][3])), fmaxf(fmaxf(s[1][1][0], s[1][1][1]), fmaxf(s[1][1][2], s[1][1][3])));
                const bool first = (k0 == 0);
                if (first || __any(fmaxf(mx0, mx1) > 8.0f)) {
                    mx0 = fmaxf(mx0, __shfl_xor(mx0, 16)); mx0 = fmaxf(mx0, __shfl_xor(mx0, 32)); mx1 = fmaxf(mx1, __shfl_xor(mx1, 16)); mx1 = fmaxf(mx1, __shfl_xor(mx1, 32));
                    const float d0 = first ? mx0 : fmaxf(mx0, 0.f), d1 = first ? mx1 : fmaxf(mx1, 0.f);
                    const float a0 = first ? 1.0f : __builtin_amdgcn_exp2f(-d0), a1 = first ? 1.0f : __builtin_amdgcn_exp2f(-d1);
                    mrun[0] += d0; mrun[1] += d1; lrun[0] *= a0; lrun[1] *= a1;
#pragma unroll
                    for (int d = 0; d < 8; ++d) { o[0][d] *= a0; o[1][d] *= a1; }
#pragma unroll
                    for (int kg = 0; kg < 2; ++kg) { s[kg][0] -= d0; s[kg][1] -= d1; }
                }
                bf16x8 pf[2];
#pragma unroll
                for (int qg = 0; qg < 2; ++qg) {
                    float pv[8]; float rs = 0.f;
#pragma unroll
                    for (int jj = 0; jj < 4; ++jj) { pv[jj] = __builtin_amdgcn_exp2f(s[0][qg][jj]); pv[4 + jj] = __builtin_amdgcn_exp2f(s[1][qg][jj]); rs += pv[jj] + pv[4 + jj]; }
                    lrun[qg] += rs;
                    pf[qg] = __builtin_bit_cast(bf16x8, (u32x4){cvt_pk_bf16(pv[0], pv[1]), cvt_pk_bf16(pv[2], pv[3]), cvt_pk_bf16(pv[4], pv[5]), cvt_pk_bf16(pv[6], pv[7])});
                }
                __builtin_amdgcn_sched_barrier(0);
                asm volatile("s_waitcnt lgkmcnt(0)" ::: "memory");
                __builtin_amdgcn_sched_barrier(0);
#pragma unroll
                for (int d = 0; d < 8; ++d) {
                    const bf16x8 vf = __builtin_bit_cast(bf16x8, (u32x4){vlo[d][0], vlo[d][1], vhi[d][0], vhi[d][1]});
                    o[0][d] = mfma16(vf, pf[0], o[0][d]); o[1][d] = mfma16(vf, pf[1], o[1][d]);
                }
            }
        }
        if (t + 2 < ntile) asm volatile("s_waitcnt vmcnt(5)" ::: "memory"); else asm volatile("s_waitcnt vmcnt(0)" ::: "memory");
        __builtin_amdgcn_s_barrier();
        bcur = bcur == 2 ? 0 : bcur + 1;
    }
#undef AT_DMA
    bf16_t* mixa = F.b16(WS_MIXA);
#pragma unroll
    for (int qg = 0; qg < 2; ++qg) {
        float lt = lrun[qg]; lt += __shfl_xor(lt, 16); lt += __shfl_xor(lt, 32);
        const float il = 1.0f / lt; bf16_t* d0 = mixa + (size_t)(qrow0 + 16 * qg + lr) * 1024 + 512 + h * 128 + 4 * g;
#pragma unroll
        for (int d = 0; d < 8; ++d) { const f32x4 v = o[qg][d] * il; *(u32x2*)(d0 + 16 * d) = (u32x2){cvt_pk_bf16(v[0], v[1]), cvt_pk_bf16(v[2], v[3])}; }
    }
}

constexpr int RU_K = 0, RU_V = 32768, RU_S = 65536;
__device__ __forceinline__ void ret_unit(const Frame& F_, int it) {
    Frame F = F_; { int t_ = F_.tid; asm volatile("" : "+v"(t_)); F.tid = t_; F.lane = t_ & 63; }
    const int bh = it >> 5, c = it & 31, b = bh >> 2, h = bh & 3, t0 = c * 128, R0 = b * 4096 + t0, w = F.wave, l0 = 16 * w;
    const int lr = F.lane & 15, g = F.lane >> 4; const float lg = lg2g(h);
    if (F.tid == 0) { unsigned* cr = (unsigned*)(F.ws + WS_CTL + 20480) + 16 * bh; unsigned sp = 0;
        while (__hip_atomic_load(cr, __ATOMIC_RELAXED, __HIP_MEMORY_SCOPE_AGENT) < 8u) { __builtin_amdgcn_s_sleep(2); if (++sp > (1u << 22)) { __hip_atomic_store((unsigned*)(F.ws + WS_CTL) + XB_TMO, 1u, __ATOMIC_RELAXED, __HIP_MEMORY_SCOPE_AGENT); break; } }
        __builtin_amdgcn_fence(__ATOMIC_ACQUIRE, "agent"); asm volatile("s_waitcnt vmcnt(0)" ::: "memory"); }
    __syncthreads();
    const char* ksrc = (const char*)(F.b16(WS_KR) + (size_t)R0 * 512 + h * 128);
    const char* vsrc = (const char*)(F.b16(WS_VTR) + (size_t)bh * 128 * 4096 + t0);
    const char* ssrc = (const char*)(F.b16(WS_SB) + (size_t)it * 16384);
#pragma unroll
    for (int i = 0; i < 4; ++i) {
        const int j = 4 * w + i, row = 4 * j + (F.lane >> 4), cs = ((F.lane & 15) ^ (row & 15)) * 16;
        __builtin_amdgcn_global_load_lds((const unsigned*)(ksrc + (size_t)row * 1024 + cs), (LAS unsigned*)(F.lds + RU_K + 1024 * j), 16, 0, 0);
        __builtin_amdgcn_global_load_lds((const unsigned*)(vsrc + (size_t)row * 8192 + cs), (LAS unsigned*)(F.lds + RU_V + 1024 * j), 16, 0, 0);
        __builtin_amdgcn_global_load_lds((const unsigned*)(ssrc + (size_t)row * 256 + cs), (LAS unsigned*)(F.lds + RU_S + 1024 * j), 16, 0, 0);
    }
    bf16x8 qf[4];
#pragma unroll
    for (int ks = 0; ks < 4; ++ks) qf[ks] = *(const bf16x8*)(F.b16(WS_QR) + (size_t)(R0 + l0 + lr) * 512 + h * 128 + 32 * ks + 8 * g);
    int koff[4];
#pragma unroll
    for (int ks = 0; ks < 4; ++ks) koff[ks] = lr * 256 + 16 * ((4 * ks + g) ^ lr);
    asm volatile("s_waitcnt vmcnt(0)" ::: "memory");
    __syncthreads();
    f32x4 xa[8], ia[8];
#pragma unroll
    for (int d = 0; d < 8; ++d) { xa[d] = (f32x4){0.f, 0.f, 0.f, 0.f}; ia[d] = (f32x4){0.f, 0.f, 0.f, 0.f}; }
#pragma unroll
    for (int d = 0; d < 8; ++d)
#pragma unroll
        for (int ks = 0; ks < 4; ++ks) { const bf16x8 sf = *(const LAS bf16x8*)(F.lds + RU_S + d * 4096 + koff[ks]); xa[d] = mfma16(sf, qf[ks], xa[d]); }
    const int li = l0 + lr, nmb = (l0 + 15) / 32 + 1;
#pragma unroll 1
    for (int mb = 0; mb < nmb; ++mb) {
        f32x4 s[2] = {(f32x4){0.f, 0.f, 0.f, 0.f}, (f32x4){0.f, 0.f, 0.f, 0.f}};
#pragma unroll
        for (int kg = 0; kg < 2; ++kg)
#pragma unroll
            for (int ks = 0; ks < 4; ++ks) { const bf16x8 kf = *(const LAS bf16x8*)(F.lds + RU_K + (32 * mb + 16 * kg) * 256 + koff[ks]); s[kg] = mfma16(kf, qf[ks], s[kg]); }
        float pv[8];
#pragma unroll
        for (int kg = 0; kg < 2; ++kg)
#pragma unroll
            for (int j = 0; j < 4; ++j) { const int mi = 32 * mb + 16 * kg + 4 * g + j; pv[4 * kg + j] = li >= mi ? s[kg][j] * __builtin_amdgcn_exp2f((float)(li - mi) * lg) : 0.f; }
        const bf16x8 pf = __builtin_bit_cast(bf16x8, (u32x4){cvt_pk_bf16(pv[0], pv[1]), cvt_pk_bf16(pv[2], pv[3]), cvt_pk_bf16(pv[4], pv[5]), cvt_pk_bf16(pv[6], pv[7])});
        const int vlo = lr * 256 + 16 * ((4 * mb + (g >> 1)) ^ lr) + 8 * (g & 1), vhi = lr * 256 + 16 * ((4 * mb + (g >> 1) + 2) ^ lr) + 8 * (g & 1);
#pragma unroll
        for (int d = 0; d < 8; ++d) {
            const u32x2 lo = *(const LAS u32x2*)(F.lds + RU_V + d * 4096 + vlo), hi = *(const LAS u32x2*)(F.lds + RU_V + d * 4096 + vhi);
            ia[d] = mfma16(__builtin_bit_cast(bf16x8, (u32x4){lo[0], lo[1], hi[0], hi[1]}), pf, ia[d]);
        }
    }
    const float xs = __builtin_amdgcn_exp2f((float)(li + 1) * lg); float ss = 0.f;
#pragma unroll
    for (int d = 0; d < 8; ++d) { ia[d] += xa[d] * xs; ss += ia[d][0] * ia[d][0] + ia[d][1] * ia[d][1] + ia[d][2] * ia[d][2] + ia[d][3] * ia[d][3]; }
    ss += __shfl_xor(ss, 16); ss += __shfl_xor(ss, 32);
    const float rstd = __builtin_amdgcn_rsqf(ss * (1.0f / 128.0f) + EPS);
    const bf16_t* gp = F.b16(WS_GR) + (size_t)(R0 + li) * 512 + h * 128 + 4 * g; bf16_t* op = F.b16(WS_MIXA) + (size_t)(R0 + li) * 1024 + h * 128 + 4 * g;
#pragma unroll
    for (int d = 0; d < 8; ++d) {
        const u32x2 gg = *(const u32x2*)(gp + 16 * d);
        const float g0 = __uint_as_float(gg[0] << 16), g1 = __uint_as_float(gg[0] & 0xffff0000u), g2 = __uint_as_float(gg[1] << 16), g3 = __uint_as_float(gg[1] & 0xffff0000u);
        *(u32x2*)(op + 16 * d) = (u32x2){cvt_pk_bf16(ia[d][0] * rstd * g0, ia[d][1] * rstd * g1), cvt_pk_bf16(ia[d][2] * rstd * g2, ia[d][3] * rstd * g3)};
    }
    __syncthreads();
}

__device__ __forceinline__ void combine_item(const Frame& F, int b);
constexpr int DW_PITCH = 544;
constexpr int DW_BYTES = 32 * DW_PITCH;
__device__ __forceinline__ void decode_stream(const Frame& F_, unsigned* qc, volatile LAS unsigned* misc) {
    Frame F = F_; { int t_ = F_.tid; asm volatile("" : "+v"(t_)); F.tid = t_; F.lane = t_ & 63; }
    constexpr int NIT = 128 * NSPLIT;
    const int wu = __builtin_amdgcn_readfirstlane(F.wave), w = wu;
    LAS unsigned char* QL = F.lds + 8 * DW_BYTES; LAS unsigned char* T = F.lds + w * DW_BYTES;
    if (F.tid == 0) { misc[2] = __hip_atomic_fetch_add(qc, 1u, __ATOMIC_RELAXED, __HIP_MEMORY_SCOPE_AGENT); misc[3] = __hip_atomic_fetch_add(qc, 1u, __ATOMIC_RELAXED, __HIP_MEMORY_SCOPE_AGENT); }
    __syncthreads();
    int it = __builtin_amdgcn_readfirstlane((int)misc[2]), itn = __builtin_amdgcn_readfirstlane((int)misc[3]);
    __syncthreads();
    if (it >= NIT) return;
#define DC_PIDX(i_) (((i_) / NSPLIT) * NPG + ((i_) % NSPLIT) * (NPG / NSPLIT) + wu)
#define DC_ISSUE(ck_, cp_, h_) do { _Pragma("unroll") for (int i = 0; i < 16; ++i) ckr[i] = *(const f32x4*)((ck_) + (size_t)(16 * (h_) + i) * 256); \
        _Pragma("unroll") for (int k2 = 0; k2 < 2; ++k2) { per[2 * k2] = *(const f32x4*)((cp_) + (size_t)(16 * (h_)) * 64 + 32 * k2); per[2 * k2 + 1] = *(const f32x4*)((cp_) + (size_t)(16 * (h_)) * 64 + 32 * k2 + 4); } } while (0)
    f32x4 ckr[16], per[4];
    int page = ((const int*)F.in(I_PT))[DC_PIDX(it)];
    { const int lr = F.lane & 15, g = F.lane >> 4; const float* ck = F.in(I_CKV) + (size_t)page * PGSZ * 256 + F.lane * 4; const float* cp = F.in(I_CPE) + (size_t)page * PGSZ * 64 + lr * 64 + 8 * g; DC_ISSUE(ck, cp, 0); }
#pragma unroll 1
    for (;;) {
    { int t_ = F.tid; asm volatile("" : "+v"(t_)); F.tid = t_; F.lane = t_ & 63; }
    const int lr = F.lane & 15, g = F.lane >> 4;
    const int b = it / NSPLIT;
    const float* ck = F.in(I_CKV) + (size_t)page * PGSZ * 256 + F.lane * 4; const float* cp = F.in(I_CPE) + (size_t)page * PGSZ * 64 + lr * 64 + 8 * g;
    int pagen = 0; if (itn < NIT) pagen = ((const int*)F.in(I_PT))[DC_PIDX(itn)];
    unsigned nx2 = 0u; if (F.tid == 0) nx2 = __hip_atomic_fetch_add(qc, 1u, __ATOMIC_RELAXED, __HIP_MEMORY_SCOPE_AGENT);
    { const bf16_t* ql = F.b16(WS_QSLAT) + ((size_t)b * 16 + lr) * 256; const bf16_t* qp = F.b16(WS_QSPE) + ((size_t)b * 16 + lr) * 64;
      *(LAS bf16x8*)(QL + w * 1024 + F.lane * 16) = *(const bf16x8*)(ql + 32 * w + 8 * g);
      if (w < 2) *(LAS bf16x8*)(QL + (8 + w) * 1024 + F.lane * 16) = *(const bf16x8*)(qp + 32 * w + 8 * g); }
    if (F.tid == 0) misc[2] = nx2;
    __syncthreads();
    const int itnn = __builtin_amdgcn_readfirstlane((int)misc[2]);
    f32x4 o[16];
#pragma unroll
    for (int cb = 0; cb < 16; ++cb) o[cb] = (f32x4){0.f, 0.f, 0.f, 0.f};
    float mrun = 0.f, lrun = 0.f;
#pragma unroll 1
    for (int hp = 0; hp < 4; ++hp) {
        f32x4 s[2] = {(f32x4){-mrun, -mrun, -mrun, -mrun}, (f32x4){-mrun, -mrun, -mrun, -mrun}};
#pragma unroll
        for (int hh = 0; hh < 2; ++hh) {
            const int h = 2 * hp + hh;
#pragma unroll
            for (int i = 0; i < 16; ++i) *(LAS u32x2*)(T + (16 * hh + i) * DW_PITCH + F.lane * 8) = (u32x2){cvt_pk_bf16(ckr[i][0], ckr[i][1]), cvt_pk_bf16(ckr[i][2], ckr[i][3])};
#pragma unroll
            for (int k2 = 0; k2 < 2; ++k2) {
                const bf16x8 pef = __builtin_bit_cast(bf16x8, (u32x4){cvt_pk_bf16(per[2 * k2][0], per[2 * k2][1]), cvt_pk_bf16(per[2 * k2][2], per[2 * k2][3]), cvt_pk_bf16(per[2 * k2 + 1][0], per[2 * k2 + 1][1]), cvt_pk_bf16(per[2 * k2 + 1][2], per[2 * k2 + 1][3])});
                s[hh] = mfma16(pef, *(const LAS bf16x8*)(QL + (8 + k2) * 1024 + F.lane * 16), s[hh]); }
            if (h + 1 < 8) DC_ISSUE(ck, cp, h + 1); else if (itn < NIT) { const float* ckn = F.in(I_CKV) + (size_t)pagen * PGSZ * 256 + F.lane * 4; const float* cpn = F.in(I_CPE) + (size_t)pagen * PGSZ * 64 + lr * 64 + 8 * g; DC_ISSUE(ckn, cpn, 0); }
        }
#pragma unroll
        for (int kb = 0; kb < 2; ++kb) {
            bf16x8 kf[2][4], qf[4];
#pragma unroll
            for (int k4 = 0; k4 < 4; ++k4) qf[k4] = *(const LAS bf16x8*)(QL + (4 * kb + k4) * 1024 + F.lane * 16);
#pragma unroll
            for (int kg = 0; kg < 2; ++kg)
#pragma unroll
                for (int k4 = 0; k4 < 4; ++k4) kf[kg][k4] = *(const LAS bf16x8*)(T + (16 * kg + lr) * DW_PITCH + 64 * (4 * kb + k4) + 16 * g);
            __builtin_amdgcn_sched_barrier(0);
            asm volatile("s_waitcnt lgkmcnt(0)" ::: "memory");
            __builtin_amdgcn_sched_barrier(0);
#pragma unroll
            for (int k4 = 0; k4 < 4; ++k4) { s[0] = mfma16(kf[0][k4], qf[k4], s[0]); s[1] = mfma16(kf[1][k4], qf[k4], s[1]); }
        }
        float mx = fmaxf(fmaxf(fmaxf(s[0][0], s[0][1]), fmaxf(s[0][2], s[0][3])), fmaxf(fmaxf(s[1][0], s[1][1]), fmaxf(s[1][2], s[1][3])));
        const bool first = (hp == 0);
        if (first || __any(mx > 8.0f)) {
            mx = fmaxf(mx, __shfl_xor(mx, 16)); mx = fmaxf(mx, __shfl_xor(mx, 32));
            const float d = first ? mx : fmaxf(mx, 0.f), al = first ? 1.0f : __builtin_amdgcn_exp2f(-d);
            mrun += d; lrun *= al;
#pragma unroll
            for (int cb = 0; cb < 16; ++cb) o[cb] *= al;
            s[0] -= d; s[1] -= d;
        }
        float pv[8]; float rs = 0.f;
#pragma unroll
        for (int j = 0; j < 4; ++j) { pv[j] = __builtin_amdgcn_exp2f(s[0][j]); pv[4 + j] = __builtin_amdgcn_exp2f(s[1][j]); rs += pv[j] + pv[4 + j]; }
        lrun += rs;
        const bf16x8 pf = __builtin_bit_cast(bf16x8, (u32x4){cvt_pk_bf16(pv[0], pv[1]), cvt_pk_bf16(pv[2], pv[3]), cvt_pk_bf16(pv[4], pv[5]), cvt_pk_bf16(pv[6], pv[7])});
        const LAS unsigned char* a0 = T + (4 * g + (lr >> 2)) * DW_PITCH + 4 * (lr & 3) * 2;
#pragma unroll
        for (int ch = 0; ch < 2; ++ch) {
            s16x4 lo[8], hi[8];
#pragma unroll
            for (int c8 = 0; c8 < 8; ++c8) {
                lo[c8] = __builtin_bit_cast(s16x4, __builtin_amdgcn_ds_read_tr16_b64_v4i16((LAS s16x4*)(a0 + 32 * (8 * ch + c8))));
                hi[c8] = __builtin_bit_cast(s16x4, __builtin_amdgcn_ds_read_tr16_b64_v4i16((LAS s16x4*)(a0 + 16 * DW_PITCH + 32 * (8 * ch + c8)))); }
            __builtin_amdgcn_sched_barrier(0);
            asm volatile("s_waitcnt lgkmcnt(0)" ::: "memory");
            __builtin_amdgcn_sched_barrier(0);
#pragma unroll
            for (int c8 = 0; c8 < 8; ++c8) { const bf16x8 vf = (bf16x8){lo[c8][0], lo[c8][1], lo[c8][2], lo[c8][3], hi[c8][0], hi[c8][1], hi[c8][2], hi[c8][3]}; o[8 * ch + c8] = mfma16(vf, pf, o[8 * ch + c8]); }
        }
    }
    lrun += __shfl_xor(lrun, 16); lrun += __shfl_xor(lrun, 32);
    __syncthreads();
    LAS f32x4* OP = (LAS f32x4*)F.lds; LAS f32x2* ML = (LAS f32x2*)(F.lds + 131072);
#pragma unroll
    for (int cb = 0; cb < 16; ++cb) OP[(w * 16 + cb) * 64 + F.lane] = o[cb];
    if (g == 0) ML[w * 16 + lr] = (f32x2){mrun, lrun};
    __syncthreads();
    float M = -INFINITY; float mj[8], lj[8];
#pragma unroll
    for (int j = 0; j < 8; ++j) { const f32x2 t = ML[j * 16 + lr]; mj[j] = t[0]; lj[j] = t[1]; M = fmaxf(M, t[0]); }
    float L = 0.f; f32x4 r0 = (f32x4){0.f, 0.f, 0.f, 0.f}, r1 = (f32x4){0.f, 0.f, 0.f, 0.f};
#pragma unroll
    for (int j = 0; j < 8; ++j) { const float wj = __builtin_amdgcn_exp2f(mj[j] - M); L += wj * lj[j]; r0 += OP[(j * 16 + 2 * w) * 64 + F.lane] * wj; r1 += OP[(j * 16 + 2 * w + 1) * 64 + F.lane] * wj; }
    { unsigned long long* po = (unsigned long long*)(F.f32(WS_PARTO) + ((size_t)it * 16 + lr) * 256 + 32 * w + 4 * g);
      __hip_atomic_store(po, ((unsigned long long)__float_as_uint(r0[1]) << 32) | __float_as_uint(r0[0]), __ATOMIC_RELAXED, __HIP_MEMORY_SCOPE_AGENT);
      __hip_atomic_store(po + 1, ((unsigned long long)__float_as_uint(r0[3]) << 32) | __float_as_uint(r0[2]), __ATOMIC_RELAXED, __HIP_MEMORY_SCOPE_AGENT);
      __hip_atomic_store(po + 8, ((unsigned long long)__float_as_uint(r1[1]) << 32) | __float_as_uint(r1[0]), __ATOMIC_RELAXED, __HIP_MEMORY_SCOPE_AGENT);
      __hip_atomic_store(po + 9, ((unsigned long long)__float_as_uint(r1[3]) << 32) | __float_as_uint(r1[2]), __ATOMIC_RELAXED, __HIP_MEMORY_SCOPE_AGENT);
      if (w == 0 && g == 0) __hip_atomic_store((unsigned long long*)(F.f32(WS_PARTML) + ((size_t)it * 16 + lr) * 2), ((unsigned long long)__float_as_uint(L) << 32) | __float_as_uint(M), __ATOMIC_RELAXED, __HIP_MEMORY_SCOPE_AGENT); }
    asm volatile("s_waitcnt vmcnt(0)" ::: "memory");
    __syncthreads();
    if (F.tid == 64) __hip_atomic_fetch_add((unsigned*)(F.ws + WS_CTL + 53248) + 16 * b, 1u, __ATOMIC_RELAXED, __HIP_MEMORY_SCOPE_AGENT);
    __syncthreads();
    if (itn >= NIT) break;
    it = itn; itn = itnn; page = pagen;
    }
#undef DC_ISSUE
#undef DC_PIDX
}

__device__ __forceinline__ void combine_item(const Frame& F_, int b) {
    Frame F = F_; { int t_ = F_.tid; asm volatile("" : "+v"(t_)); F.tid = t_; F.lane = t_ & 63; }
    LAS float* ss = (LAS float*)F.lds;
    const bf16_t* qlat = F.b16(WS_QSLAT) + (size_t)b * 16 * 256; const bf16_t* qpe = F.b16(WS_QSPE) + (size_t)b * 16 * 64;
    const float* ckv = F.out + O_KVS + (size_t)b * 4 * 256; const float* kpe = F.out + O_KRS + (size_t)b * 4 * 64;
    {
        const int pr = F.tid >> 3, sub = F.tid & 7, q = pr >> 2, kl = pr & 3, lq = q >> 2; float s = 0.f;
        if (kl <= lq) {
#pragma unroll 8
            for (int c = 0; c < 32; ++c) s += bf2f(qlat[q * 256 + sub * 32 + c]) * ckv[kl * 256 + sub * 32 + c];
#pragma unroll
            for (int c = 0; c < 8; ++c) s += bf2f(qpe[q * 64 + sub * 8 + c]) * kpe[kl * 64 + sub * 8 + c]; }
        s += __shfl_xor(s, 1); s += __shfl_xor(s, 2); s += __shfl_xor(s, 4);
        if (sub == 0) ss[pr] = kl <= lq ? s : -INFINITY;
    }
    __syncthreads();
    const int q = F.tid >> 5, c0 = (F.tid & 31) * 8, lq = q >> 2, h = q & 3;
    const float* pml = F.f32(WS_PARTML) + ((size_t)b * NSPLIT * 16 + q) * 2; const float* po = F.f32(WS_PARTO) + ((size_t)b * NSPLIT * 16 + q) * 256 + c0;
    float M = -INFINITY;
    for (int s = 0; s < NSPLIT; ++s) M = fmaxf(M, pml[(size_t)s * 32]);
    for (int kl = 0; kl < 4; ++kl) M = fmaxf(M, ss[q * 4 + kl]);
    float L = 0.f; float acc[8] = {0.f, 0.f, 0.f, 0.f, 0.f, 0.f, 0.f, 0.f};
    for (int s = 0; s < NSPLIT; ++s) {
        const float w = __builtin_amdgcn_exp2f(pml[(size_t)s * 32] - M); L += w * pml[(size_t)s * 32 + 1];
        const f32x4 a = *(const f32x4*)(po + (size_t)s * 4096), c = *(const f32x4*)(po + (size_t)s * 4096 + 4);
        acc[0] += w * a[0]; acc[1] += w * a[1]; acc[2] += w * a[2]; acc[3] += w * a[3]; acc[4] += w * c[0]; acc[5] += w * c[1]; acc[6] += w * c[2]; acc[7] += w * c[3];
    }
    for (int kl = 0; kl < 4; ++kl) {
        const float w = __builtin_amdgcn_exp2f(ss[q * 4 + kl] - M); L += w;
        for (int j = 0; j < 8; ++j) acc[j] += w * ckv[kl * 256 + c0 + j];
    }
    const float il = 1.0f / L;
    *(u32x4*)(F.b16(WS_MIXS) + (size_t)(b * 4 + lq) * 1536 + 512 + h * 256 + c0) = (u32x4){cvt_pk_bf16(acc[0] * il, acc[1] * il), cvt_pk_bf16(acc[2] * il, acc[3] * il), cvt_pk_bf16(acc[4] * il, acc[5] * il), cvt_pk_bf16(acc[6] * il, acc[7] * il)};
    __syncthreads();
}

__device__ __forceinline__ void conv_fix_panel(const Frame& F, int pm) {
    const float* conv_b = F.in(I_CONVB); const float* conv_w = F.in(I_CONVW); const bf16_t* uff = F.b16(WS_UFF); bf16_t* act = F.b16(WS_ACT);
    if (F.tid >= 352) return;
    const int j0 = F.tid * 8;
    float w[3][16], cb[16];
#pragma unroll
    for (int e = 0; e < 8; ++e) { cb[e] = conv_b[j0 + e]; cb[8 + e] = conv_b[DFF + j0 + e];
#pragma unroll
        for (int k = 0; k < 3; ++k) { w[k][e] = conv_w[(size_t)k * DFF2 + j0 + e]; w[k][8 + e] = conv_w[(size_t)k * DFF2 + DFF + j0 + e]; } }
#define CV_UNPACK(d, a_, g_) do { _Pragma("unroll") for (int e = 0; e < 4; ++e) { d[2 * e] = __uint_as_float(a_[e] << 16); d[2 * e + 1] = __uint_as_float(a_[e] & 0xffff0000u); d[8 + 2 * e] = __uint_as_float(g_[e] << 16); d[8 + 2 * e + 1] = __uint_as_float(g_[e] & 0xffff0000u); } } while (0)
#define CV_OUT(r_, um2, um1, u0) do { float o_[8]; _Pragma("unroll") for (int e = 0; e < 8; ++e) { \
            const float ca = cb[e] + w[0][e] * um2[e] + w[1][e] * um1[e] + w[2][e] * u0[e]; \
            const float cg = cb[8 + e] + w[0][8 + e] * um2[8 + e] + w[1][8 + e] * um1[8 + e] + w[2][8 + e] * u0[8 + e]; o_[e] = silu_f(cg) * ca; } \
        *(u32x4*)(act + (size_t)(r_) * DFF + j0) = (u32x4){cvt_pk_bf16(o_[0], o_[1]), cvt_pk_bf16(o_[2], o_[3]), cvt_pk_bf16(o_[4], o_[5]), cvt_pk_bf16(o_[6], o_[7])}; } while (0)
    u32x4 ra[4][4], rg[4][4];
#pragma unroll
    for (int k = 0; k < 4; ++k) { const int r0 = pm * 256 + 64 * k, t0 = r0 & 4095;
#pragma unroll
        for (int i = 0; i < 4; ++i) { const int r = i < 2 ? (t0 == 0 ? R_META + 14 + i : r0 - 2 + i) : r0 + i - 2;
            ra[k][i] = *(const u32x4*)(uff + (size_t)r * DFF2 + j0); rg[k][i] = *(const u32x4*)(uff + (size_t)r * DFF2 + DFF + j0); } }
#pragma unroll
    for (int k = 0; k < 4; ++k) { const int r0 = pm * 256 + 64 * k;
        float u0[16], u1[16], u2[16], u3[16];
        CV_UNPACK(u0, ra[k][0], rg[k][0]); CV_UNPACK(u1, ra[k][1], rg[k][1]); CV_UNPACK(u2, ra[k][2], rg[k][2]); CV_UNPACK(u3, ra[k][3], rg[k][3]);
        CV_OUT(r0, u0, u1, u2); CV_OUT(r0 + 1, u1, u2, u3); }
#undef CV_UNPACK
#undef CV_OUT
}

__device__ __forceinline__ void task_final(const Frame& F) {
    const float* g_final = F.in(I_GFINAL); const float* hp2 = F.f32(WS_HP2); const unsigned long long* sq = F.ssq(SSQ_F);
    for (int i = F.bid * 8 + F.wave; i < 16384 + 512; i += F.G * 8) {
        const int r = i < 16384 ? i : R_SAMP + (i - 16384);
        const float rstd = rstd_of(sq, r, 1.0f / 1024.0f);
        float* dst = i < 16384 ? F.out + O_YP + (size_t)i * 1024 : F.out + O_YS + (size_t)(i - 16384) * 1024;
#pragma unroll
        for (int k = 0; k < 4; ++k) { const int c = 4 * (F.lane + 64 * k); *(f32x4*)(dst + c) = *(const f32x4*)(hp2 + (size_t)r * 1024 + c) * rstd * *(const f32x4*)(g_final + c); }
    }
}

constexpr int NPHASE = 9;
template <int ONLY_PHASE> __global__ void __launch_bounds__(512, 2) fwd_kernel(Params prm) {
    extern __shared__ __attribute__((aligned(16))) unsigned char lds_raw[];
    Frame F; F.lds = (LAS unsigned char*)lds_raw; F.tid = threadIdx.x; F.lane = F.tid & 63; F.wave = __builtin_amdgcn_readfirstlane(F.tid >> 6);
    F.G = gridDim.x; F.bid = blockIdx.x; F.ws = prm.ws; F.out = prm.out; F.dup = 0;
    volatile LAS unsigned* misc = (volatile LAS unsigned*)(F.lds + LDS_MISC);
    if (F.tid < 4) misc[F.tid] = 0u;
    if (F.tid == 0) {
        LAS unsigned long long* pt = (LAS unsigned long long*)(F.lds + LDS_MISC + 64);
        pt[I_XP] = (unsigned long long)prm.x_prompt; pt[I_XS] = (unsigned long long)prm.x_sample; pt[I_CKV] = (unsigned long long)prm.cache_kv; pt[I_CPE] = (unsigned long long)prm.cache_pe;
        pt[I_SRET] = (unsigned long long)prm.state_ret; pt[I_SCONV] = (unsigned long long)prm.state_conv; pt[I_PT] = (unsigned long long)prm.page_table; pt[I_META] = (unsigned long long)prm.meta;
        pt[I_GMIX] = (unsigned long long)prm.g_mix; pt[I_WIN] = (unsigned long long)prm.w_in; pt[I_GQ] = (unsigned long long)prm.g_q; pt[I_WUQ] = (unsigned long long)prm.w_uq; pt[I_GKV] = (unsigned long long)prm.g_kv;
        pt[I_WUK] = (unsigned long long)prm.w_uk; pt[I_WUV] = (unsigned long long)prm.w_uv; pt[I_WOUT] = (unsigned long long)prm.w_out; pt[I_GFFN] = (unsigned long long)prm.g_ffn; pt[I_WUP] = (unsigned long long)prm.w_up;
        pt[I_CONVW] = (unsigned long long)prm.conv_w; pt[I_CONVB] = (unsigned long long)prm.conv_b; pt[I_WDOWN] = (unsigned long long)prm.w_down; pt[I_GFINAL] = (unsigned long long)prm.g_final;
    }
    __syncthreads();
    XcdBarrier bar; bar.bar = (unsigned*)(F.ws + WS_CTL); bar.x = 0; bar.st = misc;
    const int lo = ONLY_PHASE < 0 ? 0 : prm.ph_lo, hi = ONLY_PHASE < 0 ? NPHASE : prm.ph_hi;
    const bool fused = (hi - lo) > 1;
    if (fused) bar = xcd_barrier_post((unsigned*)(F.ws + WS_CTL), misc);
#define IN(k) ((ONLY_PHASE < 0 || ONLY_PHASE == (k)) && lo <= (k) && (k) < hi)
#define SEAM(k) do { if (IN(k) && IN((k) + 1)) xcd_barrier(bar); { int t_ = threadIdx.x; asm volatile("" : "+v"(t_)); F.tid = t_; F.lane = t_ & 63; F.wave = __builtin_amdgcn_readfirstlane(t_ >> 6); } } while (0)
    PG8_LAS unsigned char* glds = (PG8_LAS unsigned char*)lds_raw;

    if (IN(0)) { phase_prologue(F); if (PROBE_DUP & 1) { __syncthreads(); phase_prologue(F); } } SEAM(0);
    if (IN(1)) { for (int rep_ = 0; rep_ < ((PROBE_DUP & 64) ? 2 : 1); ++rep_) { F.dup = rep_;
        pg8::Gemm g{F.b16(WS_A0), F.b16(WS_BTIN), MP, 2816, 1024}; pg8::RowOrder S; S.init(67, 11, 0, F.G, F.bid); EpiIn E{F};
        pg8::gemm_phase<EpiIn, pg8::RowOrder>(glds, g, S, E);
     } F.dup = 0; } SEAM(1);
    if (IN(2)) { for (int rep_ = 0; rep_ < ((PROBE_DUP & 128) ? 2 : 1); ++rep_) { F.dup = rep_;
#ifndef P2M
#define P2M 31
#endif
        if (P2M & 1) { pg8::Gemm g{F.b16(WS_CQB), F.b16(WS_BTUQ), MP, 768, 384}; pg8::RowOrder S; S.init(65, 3, 0, F.G, F.bid); EpiUq E{F}; pg8::gemm_phase<EpiUq, pg8::RowOrder>(glds, g, S, E); }
        if (P2M & 2) { pg8::Gemm g{F.b16(WS_CQB), F.b16(WS_BTSQ), MP, 1280, 384}; pg8::RowOrder S; S.init(2, 5, 65, F.G, (F.bid + F.G - 195) % F.G); EpiSq E{F}; pg8::gemm_phase<EpiSq, pg8::RowOrder>(glds, g, S, E); }
        if (P2M & 4) { pg8::Gemm g{F.b16(WS_CKVB), F.b16(WS_BTKV), MP, 1024, 256}; pg8::RowOrder S; S.init(65, 4, 0, F.G, (F.bid + F.G - 205) % F.G); EpiKv E{F}; pg8::gemm_phase<EpiKv, pg8::RowOrder>(glds, g, S, E); }
        if (P2M & 8) task_kvlat(F);
     } F.dup = 0; } SEAM(2);
    if (IN(4)) {
        unsigned* qctr = (unsigned*)(F.ws + WS_CTL + 16384);
        const int role = (F.bid >> 3) & 1;
#define Q_PULL(qi, var) if (F.tid == 0) misc[2] = __hip_atomic_fetch_add(qctr + 64 * (qi), 1u, __ATOMIC_RELAXED, __HIP_MEMORY_SCOPE_AGENT); __syncthreads(); const int var = __builtin_amdgcn_readfirstlane((int)misc[2]); __syncthreads()
#define Q_COMPUTE() do { _Pragma("unroll 1") for (;;) { Q_PULL(4, i); if (i >= 128) break; retscan_item(F, i); }     \
                         _Pragma("unroll 1") for (;;) { Q_PULL(5, i); if (i >= 516) break; if (i < 512) sample_ret_item(F, i); else meta_ret_item(F, i - 512); } \
                         _Pragma("unroll 1") for (;;) { Q_PULL(0, i); if (i >= 260) break; if (i < 256) attn_unit(F, i); else if (F.wave == 0) attn_wave(F, 0, i - 256, R_META, 0); __syncthreads(); } \
                         _Pragma("unroll 1") for (;;) { Q_PULL(1, i); if (i >= 512) break; ret_unit(F, i); } } while (0)
#define Q_DECODE() decode_stream(F, qctr + 64 * 2, misc)
        if (role == 0) { Q_COMPUTE(); Q_DECODE(); } else { Q_DECODE(); Q_COMPUTE(); }
#pragma unroll 1
        for (;;) { Q_PULL(3, bq); if (bq >= DB) break;
            if (F.tid == 0) { unsigned* cb_ = (unsigned*)(F.ws + WS_CTL + 53248) + 16 * bq; unsigned sp = 0;
                while (__hip_atomic_load(cb_, __ATOMIC_RELAXED, __HIP_MEMORY_SCOPE_AGENT) < (unsigned)NSPLIT) { __builtin_amdgcn_s_sleep(2); if (++sp > (1u << 22)) { __hip_atomic_store((unsigned*)(F.ws + WS_CTL) + XB_TMO, 1u, __ATOMIC_RELAXED, __HIP_MEMORY_SCOPE_AGENT); break; } }
                __builtin_amdgcn_fence(__ATOMIC_ACQUIRE, "agent"); asm volatile("s_waitcnt vmcnt(0)" ::: "memory"); }
            __syncthreads();
            combine_item(F, bq); }
#undef Q_COMPUTE
#undef Q_DECODE
#undef Q_PULL
    } SEAM(4);
    if (IN(6)) { for (int rep_ = 0; rep_ < ((PROBE_DUP & 256) ? 2 : 1); ++rep_) { F.dup = rep_;
        { pg8::Gemm g{F.b16(WS_MIXA), F.b16(WS_BTOUT), MP, 1024, 1024}; pg8::RowOrder S; S.init(64, 4, 0, F.G, F.bid); EpiOut E{F}; pg8::gemm_phase<EpiOut, pg8::RowOrder>(glds, g, S, E); }
        for (int u = F.bid; u < 272; u += F.G) {
            if (u < 256) { const int rt = u >> 4, ct = u & 15; SEpiOut E{F.in(I_XS) - (size_t)R_SAMP * 1024, F.b16(WS_HPB), F.ssqw(SSQ_H), MP};
                small_gemm_unit<4>(F, F.b16(WS_MIXS) + (size_t)rt * 32 * 1536, F.b16(WS_BTOUTS) + (size_t)ct * 64 * 1536, 1536, R_SAMP + rt * 32, ct * 64, E); }
            else { const int ct = u - 256; SEpiOut E{F.in(I_META) - (size_t)R_META * 1024, F.b16(WS_HPB), F.ssqw(SSQ_H), R_META + NMETA - 1};
                small_gemm_unit<4>(F, F.b16(WS_MIXA) + (size_t)R_META * 1024, F.b16(WS_BTOUT) + (size_t)ct * 64 * 1024, 1024, R_META, ct * 64, E); }
        }
     } F.dup = 0; } SEAM(6);
    if (IN(7)) { for (int rep_ = 0; rep_ < ((PROBE_DUP & 512) ? 2 : 1); ++rep_) { F.dup = rep_;
        pg8::Gemm g{F.b16(WS_HPB), F.b16(WS_BTUP), MP, 5632, 1024}; EpiUp E{F};
#pragma unroll 1
        for (int part = 0; part < 2; ++part) { pg8::RowOrder S; if (part == 0) S.init(64, 22, 0, F.G, F.bid); else S.init(3, 22, 64, F.G, (F.bid + 128) % F.G);
            pg8::gemm_phase<EpiUp, pg8::RowOrder>(glds, g, S, E); }
     } F.dup = 0; } SEAM(7);
    if (IN(8)) {
        { pg8::Gemm g{F.b16(WS_ACT), F.b16(WS_BTDN), MP, 1024, 2816}; pg8::RowOrder S; S.init(64, 4, 0, F.G, F.bid); EpiDownNorm E{F};
          { pg8::Unit u0; if (S.next(0, u0)) conv_fix_panel(F, u0.pm); asm volatile("s_waitcnt vmcnt(0)" ::: "memory"); __syncthreads(); }
          pg8::gemm_phase<EpiDownNorm, pg8::RowOrder>(glds, g, S, E); }
        for (int u = F.bid; u < 256; u += F.G) { const int rt = u >> 4, ct = u & 15;
            SEpiDownNorm E{F.b16(WS_HPB), F.in(I_GFINAL), F.out + O_YS, F.ssq(SSQ_F), (unsigned*)(F.ws + WS_CTL + 32768) + 64 * (64 + rt), (unsigned*)(F.ws + WS_CTL) + XB_TMO};
            small_gemm_unit<4>(F, F.b16(WS_ACT) + (size_t)(R_SAMP + rt * 32) * 2816, F.b16(WS_BTDN) + (size_t)ct * 64 * 2816, 2816, R_SAMP + rt * 32, ct * 64, E); }
    }
#undef IN
#undef SEAM
}

template <int PH> static void launch_phase(Params p, int grid, hipStream_t stream) {
    static bool attr = false;
    if (!attr) { (void)hipFuncSetAttribute((const void*)fwd_kernel<PH>, hipFuncAttributeMaxDynamicSharedMemorySize, LDS_BYTES); attr = true; }
    if (PH >= 0) { p.ph_lo = PH; p.ph_hi = PH + 1; } else { p.ph_lo = 0; p.ph_hi = NPHASE; }
    hipLaunchKernelGGL(fwd_kernel<PH>, dim3(grid), dim3(512), LDS_BYTES, stream, p);
}

extern "C" void kernel_launch(void* const* d_in, const int* in_sizes, int n_in, void* d_out, int out_size, void* d_ws, size_t ws_size, hipStream_t stream) {
    static int grid = 0;
    if (grid == 0) {
        int dev = 0, cus = 0;
        (void)hipGetDevice(&dev); (void)hipDeviceGetAttribute(&cus, hipDeviceAttributeMultiprocessorCount, dev);
        grid = cus > 0 ? cus : 256;
    }
    (void)hipMemsetAsync((char*)d_ws + WS_CTL, 0, WS_ZERO_BYTES, stream);
    Params p{};
    p.x_prompt = (const float*)d_in[0]; p.x_sample = (const float*)d_in[1]; p.cache_kv = (const float*)d_in[2]; p.cache_pe = (const float*)d_in[3];
    p.state_ret = (const float*)d_in[4]; p.state_conv = (const float*)d_in[5]; p.page_table = (const int*)d_in[6]; p.meta = (const float*)d_in[7];
    p.g_mix = (const float*)d_in[8]; p.w_in = (const float*)d_in[9]; p.g_q = (const float*)d_in[10]; p.w_uq = (const float*)d_in[11]; p.g_kv = (const float*)d_in[12];
    p.w_uk = (const float*)d_in[13]; p.w_uv = (const float*)d_in[14]; p.w_out = (const float*)d_in[15]; p.g_ffn = (const float*)d_in[16]; p.w_up = (const float*)d_in[17];
    p.conv_w = (const float*)d_in[18]; p.conv_b = (const float*)d_in[19]; p.w_down = (const float*)d_in[20]; p.g_final = (const float*)d_in[21];
    p.out = (float*)d_out; p.ws = (unsigned char*)d_ws;
#if N_LAUNCH_PER_PHASE
#ifndef PROBE_PH
#define PROBE_PH -1
#endif
#define LP(k) do { launch_phase<k>(p, grid, stream); if (PROBE_PH == (k)) { (void)hipMemsetAsync((char*)d_ws + WS_CTL + 16384, 0, 65536 - 16384, stream); \
        if ((k) == 1) (void)hipMemsetAsync((char*)d_ws + WS_SSQ, 0, (size_t)2 * MP * 8, stream); \
        if ((k) == 6) (void)hipMemsetAsync((char*)d_ws + WS_SSQ + (size_t)2 * MP * 8, 0, (size_t)MP * 8, stream); \
        if ((k) == 8) (void)hipMemsetAsync((char*)d_ws + WS_SSQ + (size_t)3 * MP * 8, 0, (size_t)MP * 8, stream); \
        launch_phase<k>(p, grid, stream); } } while (0)
    LP(0); LP(1); LP(2); LP(4); LP(6); LP(7); LP(8);
#undef LP
#else
    launch_phase<-1>(p, grid, stream);
#endif
}
```

```cpp
#include <hip/hip_runtime.h>
#include <stdint.h>

#ifndef PROBE_DUP
#define PROBE_DUP 0
#endif
#ifndef N_LAUNCH_PER_PHASE
#define N_LAUNCH_PER_PHASE 0
#endif

constexpr int DM = 1024, NB = 4, SEQ = 4096, NMETA = 16, TP = 4112, DB = 128, LS = 4, NPG = 64, PGSZ = 128;
constexpr int DFF = 2816, DFF2 = 5632;
constexpr int R_META = 16384, R_SAMP = 16640, MP = 17152;
constexpr int TPP = 4160;
constexpr int NSPLIT = 8;
constexpr float EPS = 1e-6f;
constexpr float QSCALE = 0.10411754627697264f;
constexpr float KSCALE = 0.08838834764831845f;
constexpr float FIX = 16777216.0f, IFIX = 1.0f / 16777216.0f;

constexpr size_t O_YP = 0, O_YS = 16777216, O_KVP = 17301504, O_KRP = 21512192, O_RETP = 22564864, O_CONVP = 22827008,
                 O_KVS = 22872064, O_KRS = 23003136, O_RETS = 23035904, O_CONVS = 31424512;

constexpr size_t al256(size_t x) { return (x + 255) & ~(size_t)255; }
constexpr size_t WS_CTL = 0;
constexpr size_t WS_SSQ = 65536;
constexpr size_t WS_ZERO_BYTES = WS_SSQ + 8 * (size_t)MP * 8;
constexpr size_t WS_A0 = al256(WS_ZERO_BYTES);
constexpr size_t WS_BTIN = WS_A0 + (size_t)MP * 1024 * 2;
constexpr size_t WS_BTUQ = WS_BTIN + (size_t)2816 * 1024 * 2;
constexpr size_t WS_BTSQ = WS_BTUQ + (size_t)768 * 384 * 2;
constexpr size_t WS_BTKV = WS_BTSQ + (size_t)1280 * 384 * 2;
constexpr size_t WS_BTOUT = WS_BTKV + (size_t)1024 * 256 * 2;
constexpr size_t WS_BTOUTS = WS_BTOUT + (size_t)1024 * 1024 * 2;
constexpr size_t WS_BTUP = WS_BTOUTS + (size_t)1024 * 1536 * 2;
constexpr size_t WS_BTDN = WS_BTUP + (size_t)5632 * 1024 * 2;
constexpr size_t WS_ROPE = WS_BTDN + (size_t)1024 * 2816 * 2;
constexpr size_t WS_QR = al256(WS_ROPE + (size_t)4116 * 192 * 4);
constexpr size_t WS_KR = WS_QR + (size_t)MP * 512 * 2;
constexpr size_t WS_VR = WS_KR + (size_t)MP * 512 * 2;
constexpr size_t WS_GR = WS_VR + (size_t)MP * 512 * 2;
constexpr size_t WS_KTD = WS_GR + (size_t)MP * 512 * 2;
constexpr size_t WS_VTR = WS_KTD + (size_t)16 * 128 * 4096 * 2;
constexpr size_t WS_CKVRAW = WS_VTR + (size_t)16 * 128 * 4096 * 2;
constexpr size_t WS_CKVB = WS_CKVRAW + (size_t)MP * 256 * 4;
constexpr size_t WS_CQB = WS_CKVB + (size_t)MP * 256 * 2;
constexpr size_t WS_KPE = WS_CQB + (size_t)MP * 384 * 2;
constexpr size_t WS_QP = WS_KPE + (size_t)4 * TPP * 64 * 2;
constexpr size_t WS_KP = WS_QP + (size_t)R_SAMP * 768 * 2;
constexpr size_t WS_VT = WS_KP + (size_t)4 * TPP * 512 * 2;
constexpr size_t WS_QSPE = WS_VT + (size_t)16 * 128 * TPP * 2;
constexpr size_t WS_QSLAT = WS_QSPE + (size_t)512 * 256 * 2;
constexpr size_t WS_U = WS_QSLAT + (size_t)512 * 1024 * 2;
constexpr size_t WS_SB = WS_U + (size_t)512 * 16384 * 4;
constexpr size_t WS_MIXA = WS_SB + (size_t)512 * 16384 * 2;
constexpr size_t WS_MIXS = WS_MIXA + (size_t)R_SAMP * 1024 * 2;
constexpr size_t WS_PARTO = WS_MIXS + (size_t)512 * 1536 * 2;
constexpr size_t WS_PARTML = WS_PARTO + (size_t)128 * NSPLIT * 16 * 256 * 4;
constexpr size_t WS_HP1 = al256(WS_PARTML + (size_t)128 * NSPLIT * 32 * 4);
constexpr size_t WS_HPB = WS_HP1 + (size_t)MP * 1024 * 4;
constexpr size_t WS_UFF = WS_HPB + (size_t)MP * 1024 * 2;
constexpr size_t WS_ACT = WS_UFF + (size_t)MP * 5632 * 2;
constexpr size_t WS_HP2 = WS_ACT + (size_t)MP * 2816 * 2;
constexpr size_t WS_END = WS_HP2 + (size_t)MP * 1024 * 4;

constexpr int LDS_BYTES = 163840;
constexpr int LDS_MISC = 162816;

typedef unsigned short bf16_t;
typedef short bf16x8 __attribute__((ext_vector_type(8)));
typedef short s16x4 __attribute__((ext_vector_type(4)));
typedef float f32x4 __attribute__((ext_vector_type(4)));
typedef float f32x2 __attribute__((ext_vector_type(2)));
typedef unsigned u32x4 __attribute__((ext_vector_type(4)));
typedef unsigned u32x2 __attribute__((ext_vector_type(2)));
#define LAS __attribute__((address_space(3)))

struct Params {
    const float* x_prompt; const float* x_sample; const float* cache_kv; const float* cache_pe; const float* state_ret; const float* state_conv;
    const int* page_table; const float* meta; const float* g_mix; const float* w_in; const float* g_q; const float* w_uq; const float* g_kv;
    const float* w_uk; const float* w_uv; const float* w_out; const float* g_ffn; const float* w_up; const float* conv_w; const float* conv_b;
    const float* w_down; const float* g_final;
    float* out; unsigned char* ws; int ph_lo, ph_hi;
};

__device__ __forceinline__ unsigned cvt_pk_bf16(float lo, float hi) { unsigned r; asm volatile("v_cvt_pk_bf16_f32 %0, %1, %2" : "=v"(r) : "v"(lo), "v"(hi)); return r; }
__device__ __forceinline__ bf16_t f2bf(float f) { unsigned u = __float_as_uint(f); u += 0x7FFFu + ((u >> 16) & 1u); return (bf16_t)(u >> 16); }
__device__ __forceinline__ float bf2f(bf16_t b) { return __uint_as_float(((unsigned)b) << 16); }
__device__ __forceinline__ float lg2g(int h) { return h == 0 ? -0.04580368961312479f : (h == 1 ? -0.02272007650008353f : (h == 2 ? -0.011315313227834146f : -0.005646563141142063f)); }
__device__ __forceinline__ int row_pidx(int r) { return r < R_META ? 16 + (r & 4095) : (r < R_SAMP ? (r - R_META) : 4112 + ((r - R_SAMP) & 3)); }
__device__ __forceinline__ float silu_f(float x) { return x * __builtin_amdgcn_rcpf(1.0f + __builtin_amdgcn_exp2f(-1.4426950408889634f * x)); }
__device__ __forceinline__ float rstd_of(const unsigned long long* ssq, int r, float inv_n) { return __builtin_amdgcn_rsqf((float)ssq[r] * IFIX * inv_n + EPS); }
__device__ __forceinline__ float wave_sum(float v) { for (int o = 32; o >= 1; o >>= 1) v += __shfl_xor(v, o); return v; }
__device__ __forceinline__ f32x4 mfma16(bf16x8 a, bf16x8 b, f32x4 c) { return __builtin_amdgcn_mfma_f32_16x16x32_bf16(a, b, c, 0, 0, 0); }

#define XB_TMO      128
#define XB_XCNT(j)  (256  + 64 * (j))
#define XB_XSUB(j)  (1280 + 64 * (j))
#define XB_XGEN(j)  (2304 + 64 * (j))
#define XB_TOP      3328
#define XB_TOPGEN   3392
#define XCD_BAR_WORDS 3456
#define XB_SPIN_CAP (1u << 18)
__device__ __forceinline__ unsigned xb_ld(unsigned* p)              { return __hip_atomic_load(p, __ATOMIC_RELAXED, __HIP_MEMORY_SCOPE_AGENT); }
__device__ __forceinline__ unsigned xb_add(unsigned* p, unsigned v) { return __hip_atomic_fetch_add(p, v, __ATOMIC_RELAXED, __HIP_MEMORY_SCOPE_AGENT); }
__device__ __forceinline__ unsigned xb_xcc_id() { return (unsigned)__builtin_amdgcn_s_getreg((3 << 11) | 20) & 0xFu; }
#define XB_SPIN(cond, bar) do { unsigned _sp = 0; while (cond) { __builtin_amdgcn_s_sleep(1); \
    if ((++_sp & 255u) == 0u) { if (xb_ld(&(bar)[XB_TMO])) break; if (_sp > XB_SPIN_CAP) { atomicAdd(&(bar)[XB_TMO], 1u); break; } } } } while (0)
struct XcdBarrier { unsigned* bar; unsigned x; volatile LAS unsigned* st; };
__device__ __forceinline__ XcdBarrier xcd_barrier_post(unsigned* bar, volatile LAS unsigned* st) {
    XcdBarrier b; b.bar = bar; b.x = xb_xcc_id(); b.st = st;
    if (threadIdx.x == 0) (void)xb_add(&bar[XB_XCNT(b.x)], 1u);
    return b;
}
__device__ __forceinline__ void xcd_barrier_complete(unsigned* bar, unsigned x, unsigned& nloc, unsigned& nx) {
    const unsigned G = gridDim.x * gridDim.y * gridDim.z;
    unsigned sum, cnt, mine, sp = 0u;
    for (;;) {
        sum = 0u; cnt = 0u; mine = 0u;
#pragma unroll
        for (unsigned j = 0; j < 16; ++j) { const unsigned c = xb_ld(&bar[XB_XCNT(j)]); sum += c; cnt += (c > 0u) ? 1u : 0u; mine = (j == x) ? c : mine; }
        if (sum == G) break;
        __builtin_amdgcn_s_sleep(1);
        if ((++sp & 255u) == 0u) { if (xb_ld(&bar[XB_TMO])) break; if (sp > XB_SPIN_CAP) { atomicAdd(&bar[XB_TMO], 1u); break; } }
    }
    nloc = mine > 0u ? mine : 1u; nx = cnt > 0u ? cnt : 1u;
}
__device__ __forceinline__ void xcd_barrier(const XcdBarrier& b) {
    asm volatile("s_waitcnt vmcnt(0)" ::: "memory");
    __syncthreads();
    if (threadIdx.x == 0) {
        unsigned* bar = b.bar;
        __builtin_amdgcn_s_waitcnt(0);
        unsigned nloc = b.st[0], nx = b.st[1];
        if (nloc == 0u) { xcd_barrier_complete(bar, b.x, nloc, nx); b.st[0] = nloc; b.st[1] = nx; }
        const unsigned old = xb_add(&bar[XB_XSUB(b.x)], 1u);
        const unsigned gen = old / nloc;
        if (old + 1u == (gen + 1u) * nloc) {
            __builtin_amdgcn_fence(__ATOMIC_RELEASE, "agent");
            asm volatile("s_waitcnt vmcnt(0)" ::: "memory");
            const unsigned og = xb_add(&bar[XB_TOP], 1u);
            const unsigned tg = og / nx;
            if (og + 1u == (tg + 1u) * nx) xb_add(&bar[XB_TOPGEN], 1u);
            else XB_SPIN(xb_ld(&bar[XB_TOPGEN]) == tg, bar);
            __builtin_amdgcn_fence(__ATOMIC_ACQUIRE, "agent");
            xb_add(&bar[XB_XGEN(b.x)], 1u);
            asm volatile("s_waitcnt vmcnt(0)" ::: "memory");
        } else {
            XB_SPIN(xb_ld(&bar[XB_XGEN(b.x)]) == gen, bar);
            __builtin_amdgcn_fence(__ATOMIC_ACQUIRE, "agent");
            asm volatile("s_waitcnt vmcnt(0)" ::: "memory");
        }
    }
    __syncthreads();
}

namespace pg8 {
#define PG8_LAS __attribute__((address_space(3)))
constexpr int BM = 256, BK = 64, HALF = 128, HTB = HALF * BK * 2, STAGE_BYTES = 8 * HTB, NXCD = 8, WGM = 8;
__host__ __device__ __forceinline__ int lds_byte(int r, int c) { const int st = (r >> 4) * 2 + (c >> 5), rr = r & 15, cc = c & 31, ob = rr * 64 + cc * 2; return st * 1024 + (ob ^ (((ob >> 9) & 1) << 5)); }
__host__ __device__ __forceinline__ void stage_rc(int b, int& R, int& C) { const int st = b / 1024, sb = b % 1024, swz = sb ^ (((sb >> 9) & 1) << 5); R = (st >> 1) * 16 + swz / 64; C = (st & 1) * 32 + (swz % 64) / 2; }
__host__ __device__ __forceinline__ int perm32(int rho) { const int n = rho >> 4, i = rho & 15; return 8 * (i >> 2) + 4 * n + (i & 3); }
struct Unit { int pm, pn; };
struct Gemm { const bf16_t* A; const bf16_t* Bt; int M, N, K; };
struct RowOrder {
    int nM, nN, nwg, G, c, pm0;
    __device__ __forceinline__ void init(int nM_, int nN_, int pm0_, int G_, int c_) { nM = nM_; nN = nN_; nwg = nM * nN; G = G_; c = c_; pm0 = pm0_; }
    __device__ __forceinline__ bool next(int i, Unit& u) const {
        const long L = (long)i * G + c; if (L >= nwg) return false;
        int wgid = (int)L; { const int q = nwg / NXCD, r = nwg % NXCD, xcd = wgid % NXCD, off = wgid / NXCD; wgid = (xcd < r ? xcd * (q + 1) : r * (q + 1) + (xcd - r) * q) + off; }
        const int nig = WGM * nN, gid = wgid / nig, fm = gid * WGM, gsz = (nM - fm) < WGM ? (nM - fm) : WGM;
        u.pm = pm0 + fm + ((wgid % nig) % gsz); u.pn = (wgid % nig) / gsz; return true;
    }
    __device__ __forceinline__ void a_ready(const Unit&) const {}
    __device__ __forceinline__ void done(const Unit&) const {}
};

template <class Epi, class Sched>
__device__ __forceinline__ void gemm_phase(PG8_LAS unsigned char* lds, const Gemm g, const Sched& S, const Epi& E) {
    int tid_ = threadIdx.x; asm volatile("" : "+v"(tid_));
    const int tid = tid_, wid = __builtin_amdgcn_readfirstlane(tid >> 6), lane = tid & 63, wr = wid >> 2, wc = wid & 3, fr = lane & 15, fq = lane >> 4;
    const int K = g.K, nt = K / BK;
    unsigned voffA[2], voffB[2];
#pragma unroll
    for (int i = 0; i < 2; ++i) { int R, C; stage_rc(tid * 16 + i * 8192, R, C); const int Rb = Epi::PERM ? ((R & ~31) + perm32(R & 31)) : R;
        voffA[i] = (unsigned)(R * K + C) * 2u; voffB[i] = (unsigned)(Rb * K + C) * 2u; }
    const size_t kstep = (size_t)(BK * 2);
    const size_t hstep = (size_t)HALF * K * 2;
    const size_t tstep = 2 * hstep;
    const unsigned ldsw = (unsigned)wid * 1024u;
    const int aoff = lds_byte(wr * 64 + fr, fq * 8), boff = lds_byte(wc * 32 + fr, fq * 8);
#define PG8_SA(b, h) (((b) * 2 + (h)) * HTB)
#define PG8_SB(b, h) ((4 + (b) * 2 + (h)) * HTB)
#define PG8_STAGE(bufoff, gbase, voff) do { _Pragma("unroll") for (int _i = 0; _i < 2; ++_i) \
        __builtin_amdgcn_global_load_lds((const unsigned*)((const char*)(gbase) + (voff)[_i]), (PG8_LAS unsigned*)(lds + (bufoff) + ldsw + _i * 8192), 16, 0, 0); } while (0)
#define PG8_LDA(dst, b, h) do { _Pragma("unroll") for (int m = 0; m < 4; ++m) _Pragma("unroll") for (int k = 0; k < 2; ++k) dst[m][k] = *(const PG8_LAS bf16x8*)(lds + PG8_SA(b, h) + aoff + m * 2048 + k * 1024); } while (0)
#define PG8_LDB(dst, b, h) do { _Pragma("unroll") for (int n = 0; n < 2; ++n) _Pragma("unroll") for (int k = 0; k < 2; ++k) dst[n][k] = *(const PG8_LAS bf16x8*)(lds + PG8_SB(b, h) + boff + n * 2048 + k * 1024); } while (0)
#define PG8_MMA(ai, bj, At, Bt) do { __builtin_amdgcn_s_setprio(1); _Pragma("unroll") for (int m = 0; m < 4; ++m) _Pragma("unroll") for (int n = 0; n < 2; ++n) _Pragma("unroll") for (int k = 0; k < 2; ++k) \
        acc[ai][bj][m][n] = __builtin_amdgcn_mfma_f32_16x16x32_bf16(Bt[n][k], At[m][k], acc[ai][bj][m][n], 0, 0, 0); __builtin_amdgcn_s_setprio(0); } while (0)
#define PG8_WAIT_V(n) asm volatile("s_waitcnt vmcnt(" #n ")" ::: "memory")
#define PG8_WAIT_L(n) asm volatile("s_waitcnt lgkmcnt(" #n ")" ::: "memory")
#define PG8_BAR __builtin_amdgcn_s_barrier()
#define PG8_SCHED __builtin_amdgcn_sched_barrier(0)
    Unit cur, nxt; int ui = 0;
    if (!S.next(0, cur)) return;
    f32x4 acc[2][2][4][2];
#pragma unroll
    for (int a = 0; a < 2; ++a)
#pragma unroll
        for (int b = 0; b < 2; ++b)
#pragma unroll
            for (int m = 0; m < 4; ++m)
#pragma unroll
                for (int n = 0; n < 2; ++n) acc[a][b][m][n] = (f32x4){0.f, 0.f, 0.f, 0.f};
    bf16x8 At[4][2], B0[2][2], B1[2][2];
    const char* cA = (const char*)g.A + (size_t)cur.pm * tstep; const char* cB = (const char*)g.Bt + (size_t)cur.pn * tstep;
    S.a_ready(cur);
    PG8_STAGE(PG8_SB(0, 0), cB, voffB); PG8_STAGE(PG8_SA(0, 0), cA, voffA); PG8_STAGE(PG8_SB(0, 1), cB + hstep, voffB); PG8_STAGE(PG8_SA(0, 1), cA + hstep, voffA);
    if (wr == 1) PG8_BAR;
    PG8_WAIT_V(4); PG8_BAR;
    PG8_STAGE(PG8_SB(1, 0), cB + kstep, voffB); PG8_STAGE(PG8_SA(1, 0), cA + kstep, voffA); PG8_STAGE(PG8_SB(1, 1), cB + hstep + kstep, voffB);
    PG8_WAIT_V(6); PG8_BAR;
    for (;;) {
        const bool has_next = S.next(ui + 1, nxt);
        const char* nA = has_next ? (const char*)g.A + (size_t)nxt.pm * tstep : cA; const char* nB = has_next ? (const char*)g.Bt + (size_t)nxt.pn * tstep : cB;
#pragma clang loop unroll(disable)
        for (int t = 0; t < nt; t += 2) {
            const bool last = (t == nt - 2);
            const char* a1 = cA + (size_t)(t + 1) * kstep;
            const char* a2 = last ? nA : cA + (size_t)(t + 2) * kstep; const char* b2 = last ? nB : cB + (size_t)(t + 2) * kstep;
            const char* a3 = a2 + kstep; const char* b3 = b2 + kstep;
            if (last && has_next) S.a_ready(nxt);
            PG8_LDB(B0, 0, 0); PG8_SCHED; PG8_LDA(At, 0, 0); PG8_STAGE(PG8_SA(1, 1), a1 + hstep, voffA);
            PG8_WAIT_L(8); PG8_BAR; PG8_WAIT_L(0); PG8_MMA(0, 0, At, B0); PG8_BAR; PG8_SCHED;
            PG8_LDB(B1, 0, 1); PG8_STAGE(PG8_SB(0, 0), b2, voffB);
            PG8_BAR; PG8_WAIT_L(0); PG8_MMA(0, 1, At, B1); PG8_BAR;
            PG8_LDA(At, 0, 1); PG8_STAGE(PG8_SA(0, 0), a2, voffA);
            PG8_BAR; PG8_WAIT_L(0); PG8_MMA(1, 0, At, B0); PG8_BAR; PG8_SCHED;
            PG8_STAGE(PG8_SB(0, 1), b2 + hstep, voffB);
            PG8_WAIT_V(6); PG8_BAR; PG8_MMA(1, 1, At, B1); PG8_BAR;
            PG8_LDB(B0, 1, 0); PG8_SCHED; PG8_LDA(At, 1, 0); PG8_STAGE(PG8_SA(0, 1), a2 + hstep, voffA);
            PG8_WAIT_L(8); PG8_BAR; PG8_WAIT_L(0); PG8_MMA(0, 0, At, B0); PG8_BAR; PG8_SCHED;
            PG8_LDB(B1, 1, 1); PG8_STAGE(PG8_SB(1, 0), b3, voffB);
            PG8_BAR; PG8_WAIT_L(0); PG8_MMA(0, 1, At, B1); PG8_BAR;
            PG8_LDA(At, 1, 1); PG8_STAGE(PG8_SA(1, 0), a3, voffA);
            PG8_BAR; PG8_WAIT_L(0); PG8_MMA(1, 0, At, B0); PG8_BAR; PG8_SCHED;
            PG8_STAGE(PG8_SB(1, 1), b3 + hstep, voffB);
            PG8_WAIT_V(6); PG8_BAR; PG8_MMA(1, 1, At, B1); PG8_BAR;
        }
        if constexpr (!Epi::AFTER_DRAIN) E(acc, cur, wr, wc, fr, fq);
        if (!has_next) break;
#pragma unroll
        for (int a = 0; a < 2; ++a)
#pragma unroll
            for (int b = 0; b < 2; ++b)
#pragma unroll
                for (int m = 0; m < 4; ++m)
#pragma unroll
                    for (int n = 0; n < 2; ++n) acc[a][b][m][n] = (f32x4){0.f, 0.f, 0.f, 0.f};
        cur = nxt; cA = nA; cB = nB; ++ui;
    }
    PG8_WAIT_V(0);
    if (wr == 0) PG8_BAR;
    PG8_BAR;
    if constexpr (Epi::AFTER_DRAIN) E(acc, cur, wr, wc, fr, fq);
#undef PG8_SA
#undef PG8_SB
#undef PG8_STAGE
#undef PG8_LDA
#undef PG8_LDB
#undef PG8_MMA
#undef PG8_WAIT_V
#undef PG8_WAIT_L
#undef PG8_BAR
#undef PG8_SCHED
}
}

enum { I_XP = 0, I_XS, I_CKV, I_CPE, I_SRET, I_SCONV, I_PT, I_META, I_GMIX, I_WIN, I_GQ, I_WUQ, I_GKV, I_WUK, I_WUV, I_WOUT, I_GFFN, I_WUP, I_CONVW, I_CONVB, I_WDOWN, I_GFINAL, I_NPTR };
struct Frame {
    LAS unsigned char* lds; int tid, lane, wave, G, bid, dup;
    unsigned char* ws; float* out;
    __device__ __forceinline__ const float* in(int i) const { const unsigned long long v = ((const LAS unsigned long long*)(lds + LDS_MISC + 64))[i];
        const unsigned lo = __builtin_amdgcn_readfirstlane((unsigned)v), hi = __builtin_amdgcn_readfirstlane((unsigned)(v >> 32));
        return (const float*)((const __attribute__((address_space(1))) float*)(((unsigned long long)hi << 32) | lo)); }
    __device__ __forceinline__ bf16_t* b16(size_t off) const { return (bf16_t*)(ws + off); }
    __device__ __forceinline__ float* f32(size_t off) const { return (float*)(ws + off); }
    __device__ __forceinline__ unsigned long long* ssq(int which) const { return (unsigned long long*)(ws + WS_SSQ) + (size_t)which * MP; }
    __device__ __forceinline__ unsigned long long* ssqw(int which) const { return (unsigned long long*)(ws + WS_SSQ) + (size_t)(which + 4 * dup) * MP; }
    __device__ __forceinline__ const float* rope(int which) const { const float* r = (const float*)(ws + WS_ROPE); return which == 0 ? r : (which == 1 ? r + 4116 * 64 : (which == 2 ? r + 4116 * 128 : r + 4116 * 160)); }
};
enum { SSQ_KV = 0, SSQ_Q = 1, SSQ_H = 2, SSQ_F = 3 };

__device__ __forceinline__ float wsrc(int job, int k, int n, const float* pa, const float* pb, const float* pc) {
    switch (job) {
    case 0: {
        int col;
        if (n < 1024) { const int seg = n >> 9, h = (n & 511) >> 7, j = n & 127, i = (j >> 1) + 64 * (j & 1); col = seg * 512 + h * 128 + i; }
        else if (n < 2048) col = n;
        else if (n < 2304) col = 2432 + (n - 2048);
        else if (n < 2560) col = 2048 + (n - 2304);
        else { const int q = n - 2560; if (q < 128) col = 2304 + q; else if (q < 192) { const int j = q - 128, i = (j >> 1) + 32 * (j & 1); col = 2688 + i; } else return 0.f; }
        return pa[(size_t)k * 2752 + col];
    }
    case 1: {
        int col;
        if (n < 512) col = (n >> 7) * 192 + (n & 127);
        else { const int h = (n - 512) >> 6, j = (n - 512) & 63, i = (j >> 1) + 32 * (j & 1); col = h * 192 + 128 + i; }
        return pa[(size_t)k * 768 + col] * pb[k];
    }
    case 2: {
        if (n < 256) { const int h = n >> 6, j = n & 63, i = (j >> 1) + 32 * (j & 1); return pa[(size_t)k * 768 + h * 192 + 128 + i] * pb[k]; }
        const int h = (n - 256) >> 8, c = (n - 256) & 255;
        const float* a = pa + (size_t)k * 768 + h * 192; const float* b = pc + (size_t)c * 512 + h * 128;
        float s = 0.f;
        for (int d = 0; d < 128; d += 4) { const f32x4 av = *(const f32x4*)(a + d), bv = *(const f32x4*)(b + d); s += av[0] * bv[0] + av[1] * bv[1] + av[2] * bv[2] + av[3] * bv[3]; }
        return s * pb[k];
    }
    case 3: {
        if (n < 512) return pa[(size_t)k * 512 + n] * pc[k];
        return pb[(size_t)k * 512 + (n - 512)] * pc[k];
    }
    case 4: return pa[(size_t)k * 1024 + n];
    case 5: {
        if (k < 512) return pa[(size_t)k * 1024 + n];
        const int h = (k - 512) >> 8, c = (k - 512) & 255;
        const float* a = pb + (size_t)c * 512 + h * 128; const float* b = pa + (size_t)(512 + h * 128) * 1024 + n;
        float s = 0.f;
        for (int v = 0; v < 128; ++v) s += a[v] * b[(size_t)v * 1024];
        return s;
    }
    case 6: { const int col = ((n >> 7) & 1) * 2816 + (n >> 8) * 128 + (n & 127); return pa[(size_t)k * 5632 + col] * pb[k]; }
    default: return pa[(size_t)k * 1024 + n];
    }
}

__device__ __forceinline__ void heavy_tile(const Frame& F, const float* A, int lda, const float* B, int ldbk, int ldbn, bf16_t* dst, int ldd, const float* scale) {
    const int w = F.wave, li = F.lane & 15, lk = F.lane >> 4, br = w >> 1, bc = (w & 1) * 2;
    f32x4 acc0 = (f32x4){0.f, 0.f, 0.f, 0.f}, acc1 = (f32x4){0.f, 0.f, 0.f, 0.f};
    const float* ap = A + (size_t)(16 * br + li) * lda + lk;
    const float* bp0 = B + (size_t)lk * ldbk + (size_t)(16 * bc + li) * ldbn; const float* bp1 = bp0 + (size_t)16 * ldbn;
#pragma unroll 8
    for (int v0 = 0; v0 < 128; v0 += 4) {
        const float a = ap[v0], b0 = bp0[(size_t)v0 * ldbk], b1 = bp1[(size_t)v0 * ldbk];
        acc0 = __builtin_amdgcn_mfma_f32_16x16x4f32(a, b0, acc0, 0, 0, 0); acc1 = __builtin_amdgcn_mfma_f32_16x16x4f32(a, b1, acc1, 0, 0, 0);
    }
    const int i0 = 16 * br + 4 * lk;
    f32x4 sc = (f32x4){1.f, 1.f, 1.f, 1.f};
    if (scale) sc = *(const f32x4*)(scale + i0);
    acc0 *= sc; acc1 *= sc;
    *(u32x2*)(dst + (size_t)(16 * bc + li) * ldd + i0) = (u32x2){cvt_pk_bf16(acc0[0], acc0[1]), cvt_pk_bf16(acc0[2], acc0[3])};
    *(u32x2*)(dst + (size_t)(16 * bc + 16 + li) * ldd + i0) = (u32x2){cvt_pk_bf16(acc1[0], acc1[1]), cvt_pk_bf16(acc1[2], acc1[3])};
}

__device__ __forceinline__ void phase_prologue(const Frame& F) {
    {
        LAS float* tile = (LAS float*)F.lds;
        int base = 0;
#define WTILE_NK(t_, N, K, NMAJ, n0, k0) const int n0 = (NMAJ) ? ((t_) / ((K) / 64)) * 64 : ((t_) % ((N) / 64)) * 64, k0 = (NMAJ) ? ((t_) % ((K) / 64)) * 64 : ((t_) / ((N) / 64)) * 64
#define WJOB_LIGHT(job, N, K, off, ia, ib, ic, NMAJ, T0, T1) do { const float* pa = F.in(ia); const float* pb = F.in(ib); const float* pc = F.in(ic); bf16_t* dst = F.b16(off); const int cnt = (T1) - (T0); const int first = (F.bid - base % F.G + F.G) % F.G; \
            _Pragma("unroll 1") for (int t = first; t < cnt; t += 4 * F.G) { float v_[4][8]; \
                _Pragma("unroll") for (int q = 0; q < 4; ++q) { const int tq = t + q * F.G; if (tq < cnt) { WTILE_NK((T0) + tq, N, K, NMAJ, n0, k0); \
                    _Pragma("unroll") for (int i = 0; i < 8; ++i) { const int idx = F.tid + 512 * i, kk = idx >> 6, nn = idx & 63; v_[q][i] = wsrc(job, k0 + kk, n0 + nn, pa, pb, pc); } } } \
                _Pragma("unroll") for (int q = 0; q < 4; ++q) { const int tq = t + q * F.G; if (tq < cnt) { \
                    _Pragma("unroll") for (int i = 0; i < 8; ++i) { const int idx = F.tid + 512 * i, kk = idx >> 6, nn = idx & 63; tile[q * 4160 + kk * 65 + nn] = v_[q][i]; } } } \
                __syncthreads(); \
                _Pragma("unroll") for (int q = 0; q < 4; ++q) { const int tq = t + q * F.G; if (tq < cnt) { WTILE_NK((T0) + tq, N, K, NMAJ, n0, k0); \
                    _Pragma("unroll") for (int i = 0; i < 8; ++i) { const int idx = F.tid + 512 * i, nn = idx >> 6, kk = idx & 63; dst[(size_t)(n0 + nn) * (K) + k0 + kk] = f2bf(tile[q * 4160 + kk * 65 + nn]); } } } \
                __syncthreads(); } \
            base += cnt; } while (0)
        {
            const float* w_out = F.in(I_WOUT); const float* w_uv = F.in(I_WUV); const float* w_uq = F.in(I_WUQ); const float* w_uk = F.in(I_WUK); const float* g_q = F.in(I_GQ);
#pragma unroll 1
            for (int t = F.bid; t < 352; t += F.G) {
                if (t < 256) { const int n0 = (t & 15) * 64, k0 = 512 + (t >> 4) * 64, h = (k0 - 512) >> 8, c0 = (k0 - 512) & 255;
                    heavy_tile(F, w_uv + (size_t)c0 * 512 + h * 128, 512, w_out + (size_t)(512 + h * 128) * 1024 + n0, 1024, 1, F.b16(WS_BTOUTS) + (size_t)n0 * 1536 + k0, 1536, nullptr); }
                else { const int u = t - 256, n0 = 256 + (u / 6) * 64, k0 = (u % 6) * 64, h = (n0 - 256) >> 8, c0 = (n0 - 256) & 255;
                    heavy_tile(F, w_uq + (size_t)k0 * 768 + h * 192, 768, w_uk + (size_t)c0 * 512 + h * 128, 1, 512, F.b16(WS_BTSQ) + (size_t)n0 * 384 + k0, 384, g_q + k0); }
            }
            base += 352;
        }
        WJOB_LIGHT(0, 2816, 1024, WS_BTIN, I_WIN, I_WIN, I_WIN, 0, 0, 704);
        WJOB_LIGHT(1, 768, 384, WS_BTUQ, I_WUQ, I_GQ, I_GQ, 0, 0, 72);
        WJOB_LIGHT(2, 1280, 384, WS_BTSQ, I_WUQ, I_GQ, I_WUK, 1, 0, 24);
        WJOB_LIGHT(3, 1024, 256, WS_BTKV, I_WUK, I_WUV, I_GKV, 0, 0, 64);
        WJOB_LIGHT(4, 1024, 1024, WS_BTOUT, I_WOUT, I_WOUT, I_WOUT, 0, 0, 256);
        WJOB_LIGHT(5, 1024, 1536, WS_BTOUTS, I_WOUT, I_WUV, I_WUV, 0, 0, 128);
        WJOB_LIGHT(6, 5632, 1024, WS_BTUP, I_WUP, I_GFFN, I_GFFN, 0, 0, 1408);
        WJOB_LIGHT(7, 1024, 2816, WS_BTDN, I_WDOWN, I_WDOWN, I_WDOWN, 0, 0, 704);
#undef WJOB_LIGHT
#undef WTILE_NK
    }
    {
        float* c128 = (float*)F.rope(0); float* s128 = (float*)F.rope(1); float* c64 = (float*)F.rope(2); float* s64 = (float*)F.rope(3);
        for (int idx = F.bid * 512 + F.tid; idx < 4116 * 96; idx += F.G * 512) {
            const int pi = idx / 96, f = idx % 96; const int pos = pi < 4112 ? pi : 8192 + (pi - 4112);
            const bool big = f < 64; const int fi = big ? f : f - 64;
            const double r = big ? 0.8659643233600653 : 0.7498942093324559;
            double iv = 1.0; for (int q = 0; q < fi; ++q) iv *= r;
            const float inv = (float)iv; const float angf = (float)pos * inv; const double ang = (double)angf;
            const double nq = __builtin_rint(ang * 0.6366197723675814);
            double x = __builtin_fma(-nq, 1.5707963267948966, ang); x = __builtin_fma(-nq, 6.123233995736766e-17, x);
            const double x2 = x * x;
            double sn = x * (1.0 + x2 * (-1.0 / 6 + x2 * (1.0 / 120 + x2 * (-1.0 / 5040 + x2 * (1.0 / 362880 + x2 * (-1.0 / 39916800 + x2 * (1.0 / 6227020800.0)))))));
            double cs = 1.0 + x2 * (-0.5 + x2 * (1.0 / 24 + x2 * (-1.0 / 720 + x2 * (1.0 / 40320 + x2 * (-1.0 / 3628800 + x2 * (1.0 / 479001600.0 + x2 * (-1.0 / 87178291200.0)))))));
            const int q4 = ((int)nq) & 3;
            double so, co;
            if (q4 == 0) { so = sn; co = cs; } else if (q4 == 1) { so = cs; co = -sn; } else if (q4 == 2) { so = -sn; co = -cs; } else { so = -cs; co = sn; }
            if (big) { c128[pi * 64 + fi] = (float)co; s128[pi * 64 + fi] = (float)so; } else { c64[pi * 32 + fi] = (float)co; s64[pi * 32 + fi] = (float)so; }
        }
    }
    {
        bf16_t* A0 = F.b16(WS_A0); const float* xp = F.in(I_XP); const float* xs = F.in(I_XS); const float* mt = F.in(I_META); const float* gmix = F.in(I_GMIX);
        f32x4 gg[4];
#pragma unroll
        for (int i = 0; i < 4; ++i) gg[i] = *(const f32x4*)(gmix + 4 * (F.lane + 64 * i));
#pragma unroll 1
        for (int r0 = F.bid * 8 + F.wave; r0 < MP; r0 += F.G * 32) {
            const float* src[4]; f32x4 v[4][4];
#pragma unroll
            for (int q = 0; q < 4; ++q) { const int r = r0 + q * F.G * 8; src[q] = nullptr;
                if (r < R_META) src[q] = xp + (size_t)r * 1024; else if (r < R_META + NMETA) src[q] = mt + (size_t)(r - R_META) * 1024; else if (r >= R_SAMP && r < MP) src[q] = xs + (size_t)(r - R_SAMP) * 1024;
                if (src[q]) {
#pragma unroll
                    for (int i = 0; i < 4; ++i) v[q][i] = *(const f32x4*)(src[q] + 4 * (F.lane + 64 * i)); } }
#pragma unroll
            for (int q = 0; q < 4; ++q) { const int r = r0 + q * F.G * 8; if (r >= MP) continue;
                u32x2* dst = (u32x2*)(A0 + (size_t)r * 1024);
                if (!src[q]) { for (int i = 0; i < 4; ++i) dst[F.lane + 64 * i] = (u32x2){0u, 0u}; continue; }
                float ss = 0.f;
#pragma unroll
                for (int i = 0; i < 4; ++i) ss += v[q][i][0] * v[q][i][0] + v[q][i][1] * v[q][i][1] + v[q][i][2] * v[q][i][2] + v[q][i][3] * v[q][i][3];
                ss = wave_sum(ss);
                const float rstd = __builtin_amdgcn_rsqf(ss * (1.0f / 1024.0f) + EPS);
#pragma unroll
                for (int i = 0; i < 4; ++i) { const f32x4 o = v[q][i] * rstd * gg[i];
                    dst[F.lane + 64 * i] = (u32x2){cvt_pk_bf16(o[0], o[1]), cvt_pk_bf16(o[2], o[3])}; } }
        }
    }
}

__device__ __forceinline__ void ssq_add(unsigned long long* ssq, int r, float ss, int fq) {
    ss += __shfl_xor(ss, 16); ss += __shfl_xor(ss, 32);
    if (fq == 0) atomicAdd(ssq + r, (unsigned long long)(ss * FIX));
}

__device__ __forceinline__ void quad_tr_store(const f32x4 a, bf16_t* col0, size_t stride, int lane) {
    const unsigned P = cvt_pk_bf16(a[0], a[1]), Q = cvt_pk_bf16(a[2], a[3]);
    const unsigned rP = (unsigned)__builtin_amdgcn_mov_dpp((int)P, 0xB1, 0xF, 0xF, false), rQ = (unsigned)__builtin_amdgcn_mov_dpp((int)Q, 0xB1, 0xF, 0xF, false);
    const unsigned sel = (lane & 1) ? 0x03020706u : 0x05040100u;
    const unsigned W0 = __builtin_amdgcn_perm(rP, P, sel), W1 = __builtin_amdgcn_perm(rQ, Q, sel);
    const bool up = (lane & 2) != 0;
    const unsigned rv = (unsigned)__builtin_amdgcn_mov_dpp((int)(up ? W0 : W1), 0x4E, 0xF, 0xF, false);
    *(u32x2*)(col0 + (size_t)(lane & 3) * stride) = (u32x2){up ? rv : W0, up ? W1 : rv};
}
struct EpiIn {
    static constexpr bool PERM = true, AFTER_DRAIN = false;
    Frame F;
    __device__ __forceinline__ void operator()(const f32x4 (&acc)[2][2][4][2], const pg8::Unit& u, int wr, int wc, int fr, int fq) const {
        const int pn = u.pn, pm = u.pm, rb = pm * 256 + wr * 64 + fr, cl = wc * 32 + 8 * fq;
        if (pn < 4) {
            const bool isk = pn >= 2; const int i0 = cl >> 1;
            bf16_t* dstb = F.b16(isk ? WS_KR : WS_QR); bf16_t* ktd = F.b16(WS_KTD);
            const float* C = F.rope(0); const float* S = F.rope(1);
            f32x4 ncs, nsn; { const int pi0 = row_pidx(rb); ncs = *(const f32x4*)(C + pi0 * 64 + i0); nsn = *(const f32x4*)(S + pi0 * 64 + i0); }
#pragma unroll
            for (int ai = 0; ai < 2; ++ai)
#pragma unroll
                for (int m = 0; m < 4; ++m) {
                    const int r = rb + ai * 128 + m * 16;
                    const f32x4 cs = ncs, sn = nsn;
                    if (ai * 4 + m < 7) { const int pi2 = row_pidx(rb + ((ai * 4 + m + 1) >> 2) * 128 + ((ai * 4 + m + 1) & 3) * 16); ncs = *(const f32x4*)(C + pi2 * 64 + i0); nsn = *(const f32x4*)(S + pi2 * 64 + i0); }
#pragma unroll
                    for (int bj = 0; bj < 2; ++bj) {
                        const int head = 2 * (pn & 1) + bj; const f32x4 v0 = acc[ai][bj][m][0], v1 = acc[ai][bj][m][1];
                        const f32x4 x1 = (f32x4){v0[0], v0[2], v1[0], v1[2]}, x2 = (f32x4){v0[1], v0[3], v1[1], v1[3]};
                        f32x4 o1 = x1 * cs - x2 * sn, o2 = x1 * sn + x2 * cs;
                        if (isk) { o1 *= KSCALE; o2 *= KSCALE; }
                        bf16_t* d = dstb + (size_t)r * 512 + head * 128;
                        *(u32x2*)(d + i0) = (u32x2){cvt_pk_bf16(o1[0], o1[1]), cvt_pk_bf16(o1[2], o1[3])};
                        *(u32x2*)(d + 64 + i0) = (u32x2){cvt_pk_bf16(o2[0], o2[1]), cvt_pk_bf16(o2[2], o2[3])};
                        if (isk && pm < 64) {
                            const int b = r >> 12, t = r & 4095; const float dec = __builtin_amdgcn_exp2f((float)(127 - (t & 127)) * lg2g(head));
                            bf16_t* kb = ktd + ((size_t)(b * 4 + head) * 128) * 4096 + (t & ~3);
                            quad_tr_store(o1 * dec, kb + (size_t)i0 * 4096, 4096, fr); quad_tr_store(o2 * dec, kb + (size_t)(64 + i0) * 4096, 4096, fr);
                        }
                    }
                }
        } else if (pn < 6) {
            bf16_t* vr = F.b16(WS_VR); bf16_t* vtr = F.b16(WS_VTR);
#pragma unroll
            for (int ai = 0; ai < 2; ++ai)
#pragma unroll
                for (int m = 0; m < 4; ++m) {
                    const int r = rb + ai * 128 + m * 16;
#pragma unroll
                    for (int bj = 0; bj < 2; ++bj) {
                        const int head = 2 * (pn - 4) + bj; const f32x4 v0 = acc[ai][bj][m][0], v1 = acc[ai][bj][m][1];
                        if (pm >= 64) *(u32x4*)(vr + (size_t)r * 512 + head * 128 + cl) = (u32x4){cvt_pk_bf16(v0[0], v0[1]), cvt_pk_bf16(v0[2], v0[3]), cvt_pk_bf16(v1[0], v1[1]), cvt_pk_bf16(v1[2], v1[3])};
                        else {
                            const int b = r >> 12, t = r & 4095; bf16_t* vb = vtr + ((size_t)(b * 4 + head) * 128 + cl) * 4096 + (t & ~3);
                            quad_tr_store(v0, vb, 4096, fr); quad_tr_store(v1, vb + (size_t)4 * 4096, 4096, fr);
                        }
                    }
                }
        } else if (pn < 8) {
            bf16_t* gr = F.b16(WS_GR);
#pragma unroll
            for (int ai = 0; ai < 2; ++ai)
#pragma unroll
                for (int m = 0; m < 4; ++m) {
                    const int r = rb + ai * 128 + m * 16;
#pragma unroll
                    for (int bj = 0; bj < 2; ++bj) {
                        const f32x4 v0 = acc[ai][bj][m][0], v1 = acc[ai][bj][m][1];
                        *(u32x4*)(gr + (size_t)r * 512 + (pn - 6) * 256 + bj * 128 + cl) = (u32x4){cvt_pk_bf16(silu_f(v0[0]), silu_f(v0[1])), cvt_pk_bf16(silu_f(v0[2]), silu_f(v0[3])),
                                                                                                  cvt_pk_bf16(silu_f(v1[0]), silu_f(v1[1])), cvt_pk_bf16(silu_f(v1[2]), silu_f(v1[3]))};
                    }
                }
        } else if (pn == 8) {
            bf16_t* cb = F.b16(WS_CKVB); unsigned long long* sq = F.ssqw(SSQ_KV);
#pragma unroll
            for (int ai = 0; ai < 2; ++ai)
#pragma unroll
                for (int m = 0; m < 4; ++m) {
                    const int r = rb + ai * 128 + m * 16; float ss = 0.f;
#pragma unroll
                    for (int bj = 0; bj < 2; ++bj) {
                        const f32x4 v0 = acc[ai][bj][m][0], v1 = acc[ai][bj][m][1]; const int col = bj * 128 + cl;
                        *(u32x4*)(cb + (size_t)r * 256 + col) = (u32x4){cvt_pk_bf16(v0[0], v0[1]), cvt_pk_bf16(v0[2], v0[3]), cvt_pk_bf16(v1[0], v1[1]), cvt_pk_bf16(v1[2], v1[3])};
                        ss += v0[0] * v0[0] + v0[1] * v0[1] + v0[2] * v0[2] + v0[3] * v0[3] + v1[0] * v1[0] + v1[1] * v1[1] + v1[2] * v1[2] + v1[3] * v1[3];
                    }
                    ssq_add(sq, r, ss, fq);
                }
        } else {
            bf16_t* cq = F.b16(WS_CQB); unsigned long long* sq = F.ssqw(SSQ_Q);
            const float* C = F.rope(2); const float* S = F.rope(3);
#pragma unroll
            for (int ai = 0; ai < 2; ++ai)
#pragma unroll
                for (int m = 0; m < 4; ++m) {
                    const int r = rb + ai * 128 + m * 16; float ss = 0.f;
#pragma unroll
                    for (int bj = 0; bj < 2; ++bj) {
                        const f32x4 v0 = acc[ai][bj][m][0], v1 = acc[ai][bj][m][1];
                        if (pn == 9 || bj == 0) {
                            const int col = (pn == 9 ? bj * 128 : 256) + cl;
                            *(u32x4*)(cq + (size_t)r * 384 + col) = (u32x4){cvt_pk_bf16(v0[0], v0[1]), cvt_pk_bf16(v0[2], v0[3]), cvt_pk_bf16(v1[0], v1[1]), cvt_pk_bf16(v1[2], v1[3])};
                            ss += v0[0] * v0[0] + v0[1] * v0[1] + v0[2] * v0[2] + v0[3] * v0[3] + v1[0] * v1[0] + v1[1] * v1[1] + v1[2] * v1[2] + v1[3] * v1[3];
                        } else if (wc < 2) {
                            const int i0 = cl >> 1, pi = row_pidx(r);
                            const f32x4 cs = *(const f32x4*)(C + pi * 32 + i0), sn = *(const f32x4*)(S + pi * 32 + i0);
                            const f32x4 x1 = (f32x4){v0[0], v0[2], v1[0], v1[2]}, x2 = (f32x4){v0[1], v0[3], v1[1], v1[3]};
                            const f32x4 o1 = x1 * cs - x2 * sn, o2 = x1 * sn + x2 * cs;
                            const u32x2 p1 = (u32x2){cvt_pk_bf16(o1[0], o1[1]), cvt_pk_bf16(o1[2], o1[3])}, p2 = (u32x2){cvt_pk_bf16(o2[0], o2[1]), cvt_pk_bf16(o2[2], o2[3])};
                            bf16_t* kpe = F.b16(WS_KPE);
                            if (pm < 64) {
                                const int b = r >> 12, pos = 16 + (r & 4095);
                                float* o = F.out + O_KRP + ((size_t)b * TP + pos) * 64; *(f32x4*)(o + i0) = o1; *(f32x4*)(o + 32 + i0) = o2;
                                bf16_t* kb = kpe + ((size_t)b * TPP + pos) * 64; *(u32x2*)(kb + i0) = p1; *(u32x2*)(kb + 32 + i0) = p2;
                            } else if (pm == 64) {
                                const int mm = r - R_META;
                                if (mm < NMETA) {
                                    float* o = F.out + O_KRP + (size_t)mm * 64; *(f32x4*)(o + i0) = o1; *(f32x4*)(o + 32 + i0) = o2;
                                    bf16_t* kb = kpe + (size_t)mm * 64; *(u32x2*)(kb + i0) = p1; *(u32x2*)(kb + 32 + i0) = p2;
                                }
                            } else {
                                float* o = F.out + O_KRS + (size_t)(r - R_SAMP) * 64; *(f32x4*)(o + i0) = o1; *(f32x4*)(o + 32 + i0) = o2;
                            }
                        }
                    }
                    ssq_add(sq, r, ss, fq);
                }
        }
    }
};

struct EpiUq {
    static constexpr bool PERM = true, AFTER_DRAIN = false;
    Frame F;
    __device__ __forceinline__ void operator()(const f32x4 (&acc)[2][2][4][2], const pg8::Unit& u, int wr, int wc, int fr, int fq) const {
        const int pn = u.pn, rb = u.pm * 256 + wr * 64 + fr, cl = wc * 32 + 8 * fq;
        bf16_t* qp = F.b16(WS_QP); const unsigned long long* sq = F.ssq(SSQ_Q);
        const float* C = F.rope(2); const float* S = F.rope(3);
        const int i0r = ((wc & 1) * 32 + 8 * fq) >> 1;
        unsigned long long nq = sq[rb]; f32x4 ncs = (f32x4){0.f, 0.f, 0.f, 0.f}, nsn = ncs;
        if (pn == 2) { const int pi0 = row_pidx(rb); ncs = *(const f32x4*)(C + pi0 * 32 + i0r); nsn = *(const f32x4*)(S + pi0 * 32 + i0r); }
#pragma unroll
        for (int ai = 0; ai < 2; ++ai)
#pragma unroll
            for (int m = 0; m < 4; ++m) {
                const int r = rb + ai * 128 + m * 16; const float sc = __builtin_amdgcn_rsqf((float)nq * IFIX * (1.0f / 384.0f) + EPS) * QSCALE;
                const f32x4 csr = ncs, snr = nsn;
                if (ai * 4 + m < 7) { const int r2 = rb + ((ai * 4 + m + 1) >> 2) * 128 + ((ai * 4 + m + 1) & 3) * 16; nq = sq[r2];
                    if (pn == 2) { const int pi2 = row_pidx(r2); ncs = *(const f32x4*)(C + pi2 * 32 + i0r); nsn = *(const f32x4*)(S + pi2 * 32 + i0r); } }
#pragma unroll
                for (int bj = 0; bj < 2; ++bj) {
                    const f32x4 v0 = acc[ai][bj][m][0] * sc, v1 = acc[ai][bj][m][1] * sc;
                    if (pn < 2) {
                        const int head = 2 * pn + bj;
                        *(u32x4*)(qp + ((size_t)r * 4 + head) * 192 + cl) = (u32x4){cvt_pk_bf16(v0[0], v0[1]), cvt_pk_bf16(v0[2], v0[3]), cvt_pk_bf16(v1[0], v1[1]), cvt_pk_bf16(v1[2], v1[3])};
                    } else {
                        const int head = 2 * bj + (wc >> 1), i0 = i0r;
                        const f32x4 cs = csr, sn = snr;
                        const f32x4 x1 = (f32x4){v0[0], v0[2], v1[0], v1[2]}, x2 = (f32x4){v0[1], v0[3], v1[1], v1[3]};
                        const f32x4 o1 = x1 * cs - x2 * sn, o2 = x1 * sn + x2 * cs;
                        bf16_t* d = qp + ((size_t)r * 4 + head) * 192 + 128;
                        *(u32x2*)(d + i0) = (u32x2){cvt_pk_bf16(o1[0], o1[1]), cvt_pk_bf16(o1[2], o1[3])};
                        *(u32x2*)(d + 32 + i0) = (u32x2){cvt_pk_bf16(o2[0], o2[1]), cvt_pk_bf16(o2[2], o2[3])};
                    }
                }
                asm volatile("" ::: "memory");
            }
    }
};

struct EpiSq {
    static constexpr bool PERM = true, AFTER_DRAIN = false;
    Frame F;
    __device__ __forceinline__ void operator()(const f32x4 (&acc)[2][2][4][2], const pg8::Unit& u, int wr, int wc, int fr, int fq) const {
        const int pn = u.pn, rb = u.pm * 256 + wr * 64 + fr, cl = wc * 32 + 8 * fq;
        bf16_t* qpe = F.b16(WS_QSPE); bf16_t* qlat = F.b16(WS_QSLAT); const unsigned long long* sq = F.ssq(SSQ_Q);
        const float* C = F.rope(2); const float* S = F.rope(3);
#pragma unroll
        for (int ai = 0; ai < 2; ++ai)
#pragma unroll
            for (int m = 0; m < 4; ++m) {
                const int r = rb + ai * 128 + m * 16, s = r - R_SAMP; const float sc = rstd_of(sq, r, 1.0f / 384.0f) * QSCALE;
#pragma unroll
                for (int bj = 0; bj < 2; ++bj) {
                    const f32x4 v0 = acc[ai][bj][m][0] * sc, v1 = acc[ai][bj][m][1] * sc;
                    if (pn == 0) {
                        const int head = 2 * bj + (wc >> 1), i0 = ((wc & 1) * 32 + 8 * fq) >> 1, pi = row_pidx(r);
                        const f32x4 cs = *(const f32x4*)(C + pi * 32 + i0), sn = *(const f32x4*)(S + pi * 32 + i0);
                        const f32x4 x1 = (f32x4){v0[0], v0[2], v1[0], v1[2]}, x2 = (f32x4){v0[1], v0[3], v1[1], v1[3]};
                        const f32x4 o1 = x1 * cs - x2 * sn, o2 = x1 * sn + x2 * cs;
                        bf16_t* d = qpe + ((size_t)s * 4 + head) * 64;
                        *(u32x2*)(d + i0) = (u32x2){cvt_pk_bf16(o1[0], o1[1]), cvt_pk_bf16(o1[2], o1[3])};
                        *(u32x2*)(d + 32 + i0) = (u32x2){cvt_pk_bf16(o2[0], o2[1]), cvt_pk_bf16(o2[2], o2[3])};
                    } else {
                        *(u32x4*)(qlat + ((size_t)s * 4 + (pn - 1)) * 256 + bj * 128 + cl) = (u32x4){cvt_pk_bf16(v0[0], v0[1]), cvt_pk_bf16(v0[2], v0[3]), cvt_pk_bf16(v1[0], v1[1]), cvt_pk_bf16(v1[2], v1[3])};
                    }
                }
                asm volatile("" ::: "memory");
            }
    }
};

struct EpiKv {
    static constexpr bool PERM = true, AFTER_DRAIN = false;
    Frame F;
    __device__ __forceinline__ void operator()(const f32x4 (&acc)[2][2][4][2], const pg8::Unit& u, int wr, int wc, int fr, int fq) const {
        const int pn = u.pn, pm = u.pm, rb = pm * 256 + wr * 64 + fr, cl = wc * 32 + 8 * fq;
        bf16_t* kp = F.b16(WS_KP); bf16_t* vt = F.b16(WS_VT); const unsigned long long* sq = F.ssq(SSQ_KV);
        unsigned long long nq = sq[rb];
#pragma unroll
        for (int ai = 0; ai < 2; ++ai)
#pragma unroll
            for (int m = 0; m < 4; ++m) {
                const int r = rb + ai * 128 + m * 16; const float sc = __builtin_amdgcn_rsqf((float)nq * IFIX * (1.0f / 256.0f) + EPS);
                if (ai * 4 + m < 7) nq = sq[rb + ((ai * 4 + m + 1) >> 2) * 128 + ((ai * 4 + m + 1) & 3) * 16];
                const bool ismeta = pm == 64; const int b = ismeta ? 0 : (r >> 12), pos = ismeta ? (r - R_META) : 16 + (r & 4095);
                if (ismeta && pos >= NMETA) continue;
#pragma unroll
                for (int bj = 0; bj < 2; ++bj) {
                    const f32x4 v0 = acc[ai][bj][m][0] * sc, v1 = acc[ai][bj][m][1] * sc;
                    if (pn < 2) {
                        const int head = 2 * pn + bj;
                        *(u32x4*)(kp + (((size_t)b * TPP + pos) * 4 + head) * 128 + cl) = (u32x4){cvt_pk_bf16(v0[0], v0[1]), cvt_pk_bf16(v0[2], v0[3]), cvt_pk_bf16(v1[0], v1[1]), cvt_pk_bf16(v1[2], v1[3])};
                    } else {
                        const int head = 2 * (pn - 2) + bj; bf16_t* vb = vt + ((size_t)(b * 4 + head) * 128 + cl) * TPP + (pos & ~3);
                        quad_tr_store(v0, vb, TPP, fr); quad_tr_store(v1, vb + (size_t)4 * TPP, TPP, fr);
                    }
                }
            }
    }
};

struct EpiOut {
    static constexpr bool PERM = true, AFTER_DRAIN = false;
    Frame F;
    __device__ __forceinline__ void operator()(f32x4 (&acc)[2][2][4][2], const pg8::Unit& u, int wr, int wc, int fr, int fq) const {
        const int pm = u.pm, rb = pm * 256 + wr * 64 + fr, c0 = u.pn * 256 + wc * 32 + 8 * fq;
        bf16_t* hpb = F.b16(WS_HPB); unsigned long long* sq = F.ssqw(SSQ_H);
        const float* xb = F.in(I_XP);
        f32x4 nx[2][2];
#pragma unroll
        for (int bj = 0; bj < 2; ++bj)
#pragma unroll
            for (int n = 0; n < 2; ++n) nx[bj][n] = *(const f32x4*)(xb + (unsigned)(rb * 1024 + c0 + bj * 128 + n * 4));
#pragma unroll
        for (int ai = 0; ai < 2; ++ai)
#pragma unroll
            for (int m = 0; m < 4; ++m) {
                const int r = rb + ai * 128 + m * 16; float ss = 0.f;
                f32x4 cur[2][2];
#pragma unroll
                for (int bj = 0; bj < 2; ++bj)
#pragma unroll
                    for (int n = 0; n < 2; ++n) cur[bj][n] = nx[bj][n];
                if (ai * 4 + m < 7) { const int r2 = rb + ((ai * 4 + m + 1) >> 2) * 128 + ((ai * 4 + m + 1) & 3) * 16;
#pragma unroll
                    for (int bj = 0; bj < 2; ++bj)
#pragma unroll
                        for (int n = 0; n < 2; ++n) nx[bj][n] = *(const f32x4*)(xb + (unsigned)(r2 * 1024 + c0 + bj * 128 + n * 4)); }
#pragma unroll
                for (int bj = 0; bj < 2; ++bj) {
                    const f32x4 o0 = cur[bj][0] + acc[ai][bj][m][0], o1 = cur[bj][1] + acc[ai][bj][m][1];
                    *(u32x4*)(hpb + (unsigned)(r * 1024 + c0 + bj * 128)) = (u32x4){cvt_pk_bf16(o0[0], o0[1]), cvt_pk_bf16(o0[2], o0[3]), cvt_pk_bf16(o1[0], o1[1]), cvt_pk_bf16(o1[2], o1[3])};
                    ss += o0[0] * o0[0] + o0[1] * o0[1] + o0[2] * o0[2] + o0[3] * o0[3] + o1[0] * o1[0] + o1[1] * o1[1] + o1[2] * o1[2] + o1[3] * o1[3];
                }
                ssq_add(sq, r, ss, fq);
            }
    }
};

__device__ __forceinline__ f32x4 ld_bf4(const bf16_t* p) { const u32x2 t = *(const u32x2*)p; return (f32x4){__uint_as_float(t[0] << 16), __uint_as_float(t[0] & 0xffff0000u), __uint_as_float(t[1] << 16), __uint_as_float(t[1] & 0xffff0000u)}; }
__device__ __forceinline__ float dpp_ror1(float v) { return __builtin_bit_cast(float, __builtin_amdgcn_mov_dpp(__builtin_bit_cast(int, v), 0x121, 0xF, 0xF, false)); }
__device__ __forceinline__ float dpp_ror2(float v) { return __builtin_bit_cast(float, __builtin_amdgcn_mov_dpp(__builtin_bit_cast(int, v), 0x122, 0xF, 0xF, false)); }
struct EpiUp {
    static constexpr bool PERM = true, AFTER_DRAIN = false;
    Frame F;
    __device__ __forceinline__ void operator()(f32x4 (&acc)[2][2][4][2], const pg8::Unit& u, int wr, int wc, int fr, int fq) const {
        const int pm = u.pm, rb = pm * 256 + wr * 64 + fr, ca = u.pn * 128 + wc * 32 + 8 * fq;
        bf16_t* uff = F.b16(WS_UFF); bf16_t* act = F.b16(WS_ACT); const unsigned long long* sq = F.ssq(SSQ_H);
#pragma unroll
        for (int ai = 0; ai < 2; ++ai)
#pragma unroll
            for (int m = 0; m < 4; ++m) { const float sc = rstd_of(sq, rb + ai * 128 + m * 16, 1.0f / 1024.0f);
#pragma unroll
                for (int bj = 0; bj < 2; ++bj) { acc[ai][bj][m][0] *= sc; acc[ai][bj][m][1] *= sc; } }
        const bool samp = pm >= 65;
#pragma unroll
        for (int ai = 0; ai < 2; ++ai)
#pragma unroll
            for (int m = 0; m < 4; ++m) {
                const int r = rb + ai * 128 + m * 16; float* st = nullptr; bool raw;
                if (pm < 64) { const int t = r & 4095; if (t >= 4094) st = F.out + O_CONVP + ((size_t)(r >> 12) * 2 + (t - 4094)) * 5632; raw = (m == 0 && fr < 2) || (m == 3 && fr >= 14); }
                else if (samp) { const int s_ = r - R_SAMP, l = s_ & 3; if (l >= 2) st = F.out + O_CONVS + ((size_t)(s_ >> 2) * 2 + (l - 2)) * 5632; raw = false; }
                else raw = true;
                if (raw || st) {
#pragma unroll
                    for (int bj = 0; bj < 2; ++bj) { const f32x4 v0 = acc[ai][bj][m][0], v1 = acc[ai][bj][m][1]; const int c = bj * 2816 + ca;
                        if (raw) *(u32x4*)(uff + (size_t)r * 5632 + c) = (u32x4){cvt_pk_bf16(v0[0], v0[1]), cvt_pk_bf16(v0[2], v0[3]), cvt_pk_bf16(v1[0], v1[1]), cvt_pk_bf16(v1[2], v1[3])};
                        if (st) { *(f32x4*)(st + c) = v0; *(f32x4*)(st + c + 4) = v1; } }
                }
            }
        if (pm == 64) return;
        const float* cw = F.in(I_CONVW); const float* cbp = F.in(I_CONVB);
        u32x2 keep[2][4];
        if (!samp) {
#pragma unroll
            for (int n = 0; n < 2; ++n) {
                const int col = ca + 4 * n;
                const f32x4 w0a = *(const f32x4*)(cw + col), w1a = *(const f32x4*)(cw + 5632 + col), w2a = *(const f32x4*)(cw + 11264 + col), ba = *(const f32x4*)(cbp + col);
                const f32x4 w0g = *(const f32x4*)(cw + 2816 + col), w1g = *(const f32x4*)(cw + 5632 + 2816 + col), w2g = *(const f32x4*)(cw + 11264 + 2816 + col), bg = *(const f32x4*)(cbp + 2816 + col);
#pragma unroll
                for (int ai = 0; ai < 2; ++ai) {
                    f32x4 p1a = (f32x4){0.f, 0.f, 0.f, 0.f}, p2a = p1a, p1g = p1a, p2g = p1a;
#pragma unroll
                    for (int m = 0; m < 4; ++m) {
                        const int r = rb + ai * 128 + m * 16;
                        const f32x4 xa = acc[ai][0][m][n], xg = acc[ai][1][m][n];
                        f32x4 r1a, r2a, r1g, r2g;
#pragma unroll
                        for (int j = 0; j < 4; ++j) { r1a[j] = dpp_ror1(xa[j]); r2a[j] = dpp_ror2(xa[j]); r1g[j] = dpp_ror1(xg[j]); r2g[j] = dpp_ror2(xg[j]); }
                        const f32x4 u1a = fr >= 1 ? r1a : p1a, u2a = fr >= 2 ? r2a : p2a, u1g = fr >= 1 ? r1g : p1g, u2g = fr >= 2 ? r2g : p2g;
                        const f32x4 cva = ba + w0a * u2a + w1a * u1a + w2a * xa, cvg = bg + w0g * u2g + w1g * u1g + w2g * xg;
                        const u32x2 res = (u32x2){cvt_pk_bf16(silu_f(cvg[0]) * cva[0], silu_f(cvg[1]) * cva[1]), cvt_pk_bf16(silu_f(cvg[2]) * cva[2], silu_f(cvg[3]) * cva[3])};
                        if (n == 0) keep[ai][m] = res;
                        else if (!(m == 0 && fr < 2)) *(u32x4*)(act + (size_t)r * DFF + ca) = (u32x4){keep[ai][m][0], keep[ai][m][1], res[0], res[1]};
                        p1a = r1a; p2a = r2a; p1g = r1g; p2g = r2g;
                    }
                }
            }
            return;
        }
        const float* scv = F.in(I_SCONV); const int lrow = fr & 3;
#pragma unroll
        for (int n = 0; n < 2; ++n) {
            const int col = ca + 4 * n;
            const f32x4 w0a = *(const f32x4*)(cw + col), w1a = *(const f32x4*)(cw + 5632 + col), w2a = *(const f32x4*)(cw + 11264 + col), ba = *(const f32x4*)(cbp + col);
            const f32x4 w0g = *(const f32x4*)(cw + 2816 + col), w1g = *(const f32x4*)(cw + 5632 + 2816 + col), w2g = *(const f32x4*)(cw + 11264 + 2816 + col), bg = *(const f32x4*)(cbp + 2816 + col);
#pragma unroll
            for (int ai = 0; ai < 2; ++ai)
#pragma unroll
                for (int m = 0; m < 4; ++m) {
                    const int r = rb + ai * 128 + m * 16;
                    const f32x4 xa = acc[ai][0][m][n], xg = acc[ai][1][m][n];
                    f32x4 u1a, u2a, u1g, u2g;
#pragma unroll
                    for (int j = 0; j < 4; ++j) { u1a[j] = dpp_ror1(xa[j]); u2a[j] = dpp_ror2(xa[j]); u1g[j] = dpp_ror1(xg[j]); u2g[j] = dpp_ror2(xg[j]); }
                    if (lrow < 2) { const float* s1 = scv + ((size_t)((r - R_SAMP) >> 2) * 2 + 1) * 5632 + col; const f32x4 s1a = *(const f32x4*)s1, s1g = *(const f32x4*)(s1 + 2816);
                        if (lrow == 0) { u1a = s1a; u1g = s1g; u2a = *(const f32x4*)(s1 - 5632); u2g = *(const f32x4*)(s1 - 5632 + 2816); } else { u2a = s1a; u2g = s1g; } }
                    const f32x4 cva = ba + w0a * u2a + w1a * u1a + w2a * xa, cvg = bg + w0g * u2g + w1g * u1g + w2g * xg;
                    *(u32x2*)(act + (size_t)r * DFF + col) = (u32x2){cvt_pk_bf16(silu_f(cvg[0]) * cva[0], silu_f(cvg[1]) * cva[1]), cvt_pk_bf16(silu_f(cvg[2]) * cva[2], silu_f(cvg[3]) * cva[3])};
                }
        }
    }
};

struct EpiDownNorm {
    static constexpr bool PERM = false, AFTER_DRAIN = true;
    Frame F;
    __device__ __forceinline__ void operator()(f32x4 (&acc)[2][2][4][2], const pg8::Unit& u, int wr, int wc, int fr, int fq) const {
        const int pm = u.pm, rb = pm * 256 + wr * 64 + fr, c0 = u.pn * 256 + wc * 32 + 4 * fq;
        const bf16_t* hpb = F.b16(WS_HPB); unsigned long long* sq = F.ssq(SSQ_F);
        unsigned* cnt = (unsigned*)(F.ws + WS_CTL + 32768) + 64 * pm; unsigned* tmo = (unsigned*)(F.ws + WS_CTL) + XB_TMO;
        {
            f32x4 nx[2][2];
#pragma unroll
            for (int bj = 0; bj < 2; ++bj)
#pragma unroll
                for (int n = 0; n < 2; ++n) nx[bj][n] = ld_bf4(hpb + (unsigned)(rb * 1024 + c0 + bj * 128 + n * 16));
#pragma unroll
            for (int ai = 0; ai < 2; ++ai)
#pragma unroll
                for (int m = 0; m < 4; ++m) {
                    const int r = rb + ai * 128 + m * 16; float ss = 0.f;
#pragma unroll
                    for (int bj = 0; bj < 2; ++bj)
#pragma unroll
                        for (int n = 0; n < 2; ++n) { const f32x4 o = nx[bj][n] + acc[ai][bj][m][n]; acc[ai][bj][m][n] = o; ss += o[0] * o[0] + o[1] * o[1] + o[2] * o[2] + o[3] * o[3]; }
                    if (ai * 4 + m < 7) { const int r2 = rb + ((ai * 4 + m + 1) >> 2) * 128 + ((ai * 4 + m + 1) & 3) * 16;
#pragma unroll
                        for (int bj = 0; bj < 2; ++bj)
#pragma unroll
                            for (int n = 0; n < 2; ++n) nx[bj][n] = ld_bf4(hpb + (unsigned)(r2 * 1024 + c0 + bj * 128 + n * 16)); }
                    ssq_add(sq, r, ss, fq);
                }
        }
        asm volatile("s_waitcnt vmcnt(0)" ::: "memory");
        if ((threadIdx.x & 63) == 0) {
            __hip_atomic_fetch_add(cnt, 1u, __ATOMIC_RELAXED, __HIP_MEMORY_SCOPE_AGENT);
            unsigned sp = 0;
            while (__hip_atomic_load(cnt, __ATOMIC_RELAXED, __HIP_MEMORY_SCOPE_AGENT) < 32u) { __builtin_amdgcn_s_sleep(1); if (++sp > (1u << 22)) { __hip_atomic_store(tmo, 1u, __ATOMIC_RELAXED, __HIP_MEMORY_SCOPE_AGENT); break; } }
        }
        asm volatile("" ::: "memory");
        const float* gfin = F.in(I_GFINAL); float* y = F.out + O_YP;
        f32x4 gf[2][2];
#pragma unroll
        for (int bj = 0; bj < 2; ++bj)
#pragma unroll
            for (int n = 0; n < 2; ++n) gf[bj][n] = *(const f32x4*)(gfin + c0 + bj * 128 + n * 16);
#pragma unroll
        for (int ai = 0; ai < 2; ++ai)
#pragma unroll
            for (int m = 0; m < 4; ++m) {
                const int r = rb + ai * 128 + m * 16;
                const float rstd = __builtin_amdgcn_rsqf((float)__hip_atomic_load(sq + r, __ATOMIC_RELAXED, __HIP_MEMORY_SCOPE_AGENT) * IFIX * (1.0f / 1024.0f) + EPS);
#pragma unroll
                for (int bj = 0; bj < 2; ++bj)
#pragma unroll
                    for (int n = 0; n < 2; ++n) *(f32x4*)(y + (unsigned)(r * 1024 + c0 + bj * 128 + n * 16)) = acc[ai][bj][m][n] * rstd * gf[bj][n];
            }
    }
};

template <int NCB, class Epi> __device__ __forceinline__ void small_gemm_unit(const Frame& F, const bf16_t* A, const bf16_t* Bt, int K, int row0, int col0, const Epi& E) {
    const int lr = F.lane & 15, g = F.lane >> 4, w = F.wave, nks = K >> 8;
    f32x4 acc[2][NCB];
#pragma unroll
    for (int rb = 0; rb < 2; ++rb)
#pragma unroll
        for (int cb = 0; cb < NCB; ++cb) acc[rb][cb] = (f32x4){0.f, 0.f, 0.f, 0.f};
    const bf16_t* ap = A + (size_t)lr * K + (size_t)w * nks * 32 + 8 * g; const bf16_t* bp = Bt + (size_t)lr * K + (size_t)w * nks * 32 + 8 * g;
#pragma unroll 6
    for (int i = 0; i < nks; ++i) {
        const bf16x8 a0 = *(const bf16x8*)(ap + 32 * i), a1 = *(const bf16x8*)(ap + (size_t)16 * K + 32 * i);
#pragma unroll
        for (int cb = 0; cb < NCB; ++cb) { const bf16x8 bf = *(const bf16x8*)(bp + (size_t)(16 * cb) * K + 32 * i); acc[0][cb] = mfma16(bf, a0, acc[0][cb]); acc[1][cb] = mfma16(bf, a1, acc[1][cb]); }
    }
    LAS f32x4* P = (LAS f32x4*)F.lds;
#pragma unroll
    for (int rb = 0; rb < 2; ++rb)
#pragma unroll
        for (int cb = 0; cb < NCB; ++cb) P[((w * 2 + rb) * NCB + cb) * 64 + F.lane] = acc[rb][cb];
    __syncthreads();
    const int row = F.tid >> 4, cg = F.tid & 15;
    f32x4 v[NCB / 4];
#pragma unroll
    for (int q = 0; q < NCB / 4; ++q) {
        const int idx = (((row >> 4) * NCB + 4 * q + (cg >> 2)) * 64) + (cg & 3) * 16 + (row & 15);
        v[q] = P[idx];
#pragma unroll
        for (int ww = 1; ww < 8; ++ww) v[q] += P[ww * (2 * NCB * 64) + idx];
    }
    E.template run<NCB / 4>(F, row0 + row, col0 + 4 * cg, v, cg);
    __syncthreads();
}
__device__ __forceinline__ float row16_sum(float ss) { ss += __shfl_xor(ss, 1); ss += __shfl_xor(ss, 2); ss += __shfl_xor(ss, 4); ss += __shfl_xor(ss, 8); return ss; }
struct SEpiOut {
    const float* xb; bf16_t* hpb; unsigned long long* ssq; int rmax;
    template <int NQ> __device__ __forceinline__ void run(const Frame& F, int r, int c, const f32x4 (&v)[NQ], int cg) const {
        float ss = 0.f;
#pragma unroll
        for (int q = 0; q < NQ; ++q) { const int cc = c + 64 * q;
            const f32x4 o = *(const f32x4*)(xb + (size_t)(r < rmax ? r : rmax) * 1024 + cc) + v[q];
            *(u32x2*)(hpb + (size_t)r * 1024 + cc) = (u32x2){cvt_pk_bf16(o[0], o[1]), cvt_pk_bf16(o[2], o[3])};
            ss += o[0] * o[0] + o[1] * o[1] + o[2] * o[2] + o[3] * o[3]; }
        ss = row16_sum(ss);
        if (cg == 0) atomicAdd(ssq + r, (unsigned long long)(ss * FIX));
    }
};
struct SEpiDownNorm {
    const bf16_t* hpb; const float* g_final; float* y; unsigned long long* ssq; unsigned* cnt; unsigned* tmo;
    template <int NQ> __device__ __forceinline__ void run(const Frame& F, int r, int c, const f32x4 (&v)[NQ], int cg) const {
        const f32x4 o = ld_bf4(hpb + (size_t)r * 1024 + c) + v[0];
        float ss = row16_sum(o[0] * o[0] + o[1] * o[1] + o[2] * o[2] + o[3] * o[3]);
        if (cg == 0) atomicAdd(ssq + r, (unsigned long long)(ss * FIX));
        asm volatile("s_waitcnt vmcnt(0)" ::: "memory");
        __syncthreads();
        if (F.tid == 0) {
            __hip_atomic_fetch_add(cnt, 1u, __ATOMIC_RELAXED, __HIP_MEMORY_SCOPE_AGENT);
            unsigned sp = 0;
            while (__hip_atomic_load(cnt, __ATOMIC_RELAXED, __HIP_MEMORY_SCOPE_AGENT) < 16u) { __builtin_amdgcn_s_sleep(1); if (++sp > (1u << 22)) { __hip_atomic_store(tmo, 1u, __ATOMIC_RELAXED, __HIP_MEMORY_SCOPE_AGENT); break; } }
        }
        __syncthreads();
        const float rstd = __builtin_amdgcn_rsqf((float)__hip_atomic_load(ssq + r, __ATOMIC_RELAXED, __HIP_MEMORY_SCOPE_AGENT) * IFIX * (1.0f / 1024.0f) + EPS);
        *(f32x4*)(y + (size_t)(r - R_SAMP) * 1024 + c) = o * rstd * *(const f32x4*)(g_final + c);
    }
};

__device__ __forceinline__ void task_kvlat(const Frame& F) {
    const bf16_t* raw = F.b16(WS_CKVB); const unsigned long long* sq = F.ssq(SSQ_KV); float* out = F.out;
    const f32x4 g = *(const f32x4*)(F.in(I_GKV) + 4 * F.lane);
    constexpr int NR = R_META + NMETA + 512;
    for (int i0 = F.bid * 8 + F.wave; i0 < NR; i0 += F.G * 32) {
        f32x4 v[4]; int rr[4];
#pragma unroll
        for (int q = 0; q < 4; ++q) { const int i = i0 + q * F.G * 8; rr[q] = i < R_META + NMETA ? i : R_SAMP + (i - (R_META + NMETA));
            if (i < NR) v[q] = ld_bf4(raw + (size_t)rr[q] * 256 + 4 * F.lane) * rstd_of(sq, rr[q], 1.0f / 256.0f) * g; }
#pragma unroll
        for (int q = 0; q < 4; ++q) { const int i = i0 + q * F.G * 8, r = rr[q]; if (i >= NR) continue;
            if (r < R_META) *(f32x4*)(out + O_KVP + ((size_t)(r >> 12) * TP + 16 + (r & 4095)) * 256 + 4 * F.lane) = v[q];
            else if (r < R_SAMP) { for (int b = 0; b < 4; ++b) *(f32x4*)(out + O_KVP + ((size_t)b * TP + (r - R_META)) * 256 + 4 * F.lane) = v[q]; }
            else *(f32x4*)(out + O_KVS + (size_t)(r - R_SAMP) * 256 + 4 * F.lane) = v[q]; }
    }
    for (int idx = F.bid * 512 + F.tid; idx < 3 * NMETA * 64; idx += F.G * 512) {
        const int b = 1 + idx / (NMETA * 64), e = idx % (NMETA * 64); out[O_KRP + (size_t)b * TP * 64 + e] = out[O_KRP + e]; }
}
__device__ __forceinline__ void task_uc(const Frame& F) {
    const bf16_t* vtr = F.b16(WS_VTR); const bf16_t* ktd = F.b16(WS_KTD); float* U = F.f32(WS_U);
    const int lr = F.lane & 15, g = F.lane >> 4;
    for (int it = F.bid; it < 512; it += F.G) {
        const int bh = it >> 5, c = it & 31, t0 = c * 128;
        bf16x8 af[4];
#pragma unroll
        for (int ks = 0; ks < 4; ++ks) af[ks] = *(const bf16x8*)(vtr + ((size_t)bh * 128 + 16 * F.wave + lr) * 4096 + t0 + 32 * ks + 8 * g);
#pragma unroll 2
        for (int db = 0; db < 8; ++db) {
            f32x4 a = (f32x4){0.f, 0.f, 0.f, 0.f};
#pragma unroll
            for (int ks = 0; ks < 4; ++ks) { const bf16x8 bf = *(const bf16x8*)(ktd + ((size_t)bh * 128 + 16 * db + lr) * 4096 + t0 + 32 * ks + 8 * g); a = mfma16(af[ks], bf, a); }
            float* o = U + ((size_t)it * 128 + 16 * F.wave + 4 * g) * 128 + 16 * db + lr;
#pragma unroll
            for (int j = 0; j < 4; ++j) o[(size_t)j * 128] = a[j];
        }
    }
}

constexpr int RS_V = 0, RS_K = 4096, RS_BUF = 36864;
__device__ __forceinline__ void retscan_item(const Frame& F_, int it) {
    Frame F = F_; { int t_ = F_.tid; asm volatile("" : "+v"(t_)); F.tid = t_; F.lane = t_ & 63; }
    const int bh = it >> 3, dvb = it & 7, h = bh & 3, w = F.wave, lr = F.lane & 15, g = F.lane >> 4; const float lg = lg2g(h);
    f32x4 acc = (f32x4){0.f, 0.f, 0.f, 0.f};
    { const bf16_t* kr = F.b16(WS_KR) + (size_t)R_META * 512 + h * 128 + 16 * w + 4 * g; const bf16_t* vr = F.b16(WS_VR) + (size_t)R_META * 512 + h * 128 + 16 * dvb + lr;
#pragma unroll 4
      for (int m = 0; m < NMETA; ++m) { const u32x2 kk = *(const u32x2*)(kr + (size_t)m * 512); const float vv = bf2f(vr[(size_t)m * 512]) * __builtin_amdgcn_exp2f((float)(15 - m) * lg);
          acc[0] += vv * __uint_as_float(kk[0] << 16); acc[1] += vv * __uint_as_float(kk[0] & 0xffff0000u); acc[2] += vv * __uint_as_float(kk[1] << 16); acc[3] += vv * __uint_as_float(kk[1] & 0xffff0000u); } }
    const float g128 = __builtin_amdgcn_exp2f(128.0f * lg);
    unsigned so[5];
#pragma unroll
    for (int i = 0; i < 4; ++i) { const int row = 16 * w + 4 * i + (F.lane >> 4); so[i] = (unsigned)(row * 8192 + ((F.lane & 15) ^ (row & 15)) * 16); }
    { const int row = 4 * (w & 3) + (F.lane >> 4); so[4] = (unsigned)((16 * dvb + row) * 8192 + ((F.lane & 15) ^ (row & 15)) * 16); }
    const char* ksrc = (const char*)(F.b16(WS_KTD) + (size_t)bh * 128 * 4096); const char* vsrc = (const char*)(F.b16(WS_VTR) + (size_t)bh * 128 * 4096);
#define RS_DMA(c_, buf) do { LAS unsigned char* B_ = F.lds + (buf) * RS_BUF; const size_t cb_ = (size_t)(c_) * 256; \
        _Pragma("unroll") for (int i_ = 0; i_ < 4; ++i_) __builtin_amdgcn_global_load_lds((const unsigned*)(ksrc + cb_ + so[i_]), (LAS unsigned*)(B_ + RS_K + 1024 * (4 * w + i_)), 16, 0, 0); \
        __builtin_amdgcn_global_load_lds((const unsigned*)(vsrc + cb_ + so[4]), (LAS unsigned*)(B_ + RS_V + 1024 * (w & 3)), 16, 0, 0); } while (0)
    int koff[4];
#pragma unroll
    for (int ks = 0; ks < 4; ++ks) koff[ks] = lr * 256 + 16 * ((4 * ks + g) ^ lr);
    bf16_t* sbp = F.b16(WS_SB) + (size_t)bh * 32 * 16384 + (size_t)(16 * dvb + lr) * 128 + 16 * w + 4 * g;
    asm volatile("s_waitcnt vmcnt(0)" ::: "memory");
    RS_DMA(0, 0); RS_DMA(1, 1); RS_DMA(2, 2);
    asm volatile("s_waitcnt vmcnt(10)" ::: "memory");
    __builtin_amdgcn_s_barrier();
    int bcur = 0;
#pragma unroll 1
    for (int c = 0; c < 32; ++c) {
        if (c + 3 < 32) { RS_DMA(c + 3, (bcur + 3) & 3); }
        const LAS unsigned char* Bt = F.lds + bcur * RS_BUF;
        bf16x8 kf[4], vf[4];
#pragma unroll
        for (int ks = 0; ks < 4; ++ks) { kf[ks] = *(const LAS bf16x8*)(Bt + RS_K + w * 4096 + koff[ks]); vf[ks] = *(const LAS bf16x8*)(Bt + RS_V + koff[ks]); }
        __hip_atomic_store((unsigned long long*)(sbp + (size_t)c * 16384), ((unsigned long long)cvt_pk_bf16(acc[2], acc[3]) << 32) | cvt_pk_bf16(acc[0], acc[1]), __ATOMIC_RELAXED, __HIP_MEMORY_SCOPE_AGENT);
        acc *= g128;
#pragma unroll
        for (int ks = 0; ks < 4; ++ks) acc = mfma16(kf[ks], vf[ks], acc);
        if (c + 3 < 32) { if (c == 0) asm volatile("s_waitcnt vmcnt(11)" ::: "memory"); else asm volatile("s_waitcnt vmcnt(12)" ::: "memory"); } else if (c + 2 < 32) asm volatile("s_waitcnt vmcnt(6)" ::: "memory"); else asm volatile("s_waitcnt vmcnt(0)" ::: "memory");
        __builtin_amdgcn_s_barrier();
        bcur = (bcur + 1) & 3;
    }
#undef RS_DMA
    float* o = F.out + O_RETP + (size_t)bh * 16384 + (size_t)(16 * w + 4 * g) * 128 + 16 * dvb + lr;
#pragma unroll
    for (int j = 0; j < 4; ++j) o[(size_t)j * 128] = acc[j];
    asm volatile("s_waitcnt vmcnt(0)" ::: "memory");
    __syncthreads();
    if (F.tid == 64) __hip_atomic_fetch_add((unsigned*)(F.ws + WS_CTL + 20480) + 16 * bh, 1u, __ATOMIC_RELAXED, __HIP_MEMORY_SCOPE_AGENT);
    __syncthreads();
}

__device__ __forceinline__ void task_scan(const Frame& F) {
    const bf16_t* kr = F.b16(WS_KR); const bf16_t* vr = F.b16(WS_VR); const float* U = F.f32(WS_U); bf16_t* SB = F.b16(WS_SB);
    for (int it = F.bid; it < 256; it += F.G) {
        const int bh = it >> 4, sl = it & 15, h = bh & 3, b = bh >> 2;
        const int e0 = sl * 1024 + F.tid * 2, dv = e0 >> 7, dk = e0 & 127;
        const float lg = lg2g(h);
        float s0 = 0.f, s1 = 0.f;
        for (int m = 0; m < NMETA; ++m) {
            const float w = __builtin_amdgcn_exp2f((float)(15 - m) * lg);
            const float vv = bf2f(vr[(size_t)(R_META + m) * 512 + h * 128 + dv]) * w;
            s0 += vv * bf2f(kr[(size_t)(R_META + m) * 512 + h * 128 + dk]); s1 += vv * bf2f(kr[(size_t)(R_META + m) * 512 + h * 128 + dk + 1]);
        }
        const float g128 = __builtin_amdgcn_exp2f(128.0f * lg);
        f32x2 uu[32];
#pragma unroll
        for (int c = 0; c < 32; ++c) uu[c] = *(const f32x2*)(U + ((size_t)bh * 32 + c) * 16384 + e0);
#pragma unroll
        for (int c = 0; c < 32; ++c) {
            *(unsigned*)(SB + ((size_t)bh * 32 + c) * 16384 + e0) = cvt_pk_bf16(s0, s1);
            s0 = g128 * s0 + uu[c][0]; s1 = g128 * s1 + uu[c][1];
        }
        float* o = F.out + O_RETP + (size_t)bh * 16384;
        o[(size_t)dk * 128 + dv] = s0; o[(size_t)(dk + 1) * 128 + dv] = s1;
    }
}

__device__ __forceinline__ void meta_ret_item(const Frame& F, int h_item) {
    const bf16_t* qr = F.b16(WS_QR); const bf16_t* kr = F.b16(WS_KR); const bf16_t* vr = F.b16(WS_VR); const bf16_t* gr = F.b16(WS_GR); bf16_t* mixa = F.b16(WS_MIXA);
    LAS float* sc = (LAS float*)F.lds; LAS float* ob = sc + 256;
    { const int h = h_item;
        const float lg = lg2g(h);
        if (F.tid < 256) {
            const int m = F.tid >> 4, s = F.tid & 15; float d = 0.f;
            if (s <= m) { for (int k = 0; k < 128; ++k) d += bf2f(qr[(size_t)(R_META + m) * 512 + h * 128 + k]) * bf2f(kr[(size_t)(R_META + s) * 512 + h * 128 + k]); d *= __builtin_amdgcn_exp2f((float)(m - s) * lg); }
            sc[F.tid] = d;
        }
        __syncthreads();
        for (int i = 0; i < 4; ++i) {
            const int idx = F.tid + 512 * i, m = idx >> 7, dv = idx & 127; float o = 0.f;
            for (int s = 0; s <= m; ++s) o += sc[m * 16 + s] * bf2f(vr[(size_t)(R_META + s) * 512 + h * 128 + dv]);
            ob[idx] = o;
        }
        __syncthreads();
        for (int m = F.wave; m < 16; m += 8) {
            const float a = ob[m * 128 + F.lane], b2 = ob[m * 128 + 64 + F.lane];
            const float rstd = __builtin_amdgcn_rsqf(wave_sum(a * a + b2 * b2) * (1.0f / 128.0f) + EPS);
            const size_t ro = (size_t)(R_META + m);
            mixa[ro * 1024 + h * 128 + F.lane] = f2bf(a * rstd * bf2f(gr[ro * 512 + h * 128 + F.lane]));
            mixa[ro * 1024 + h * 128 + 64 + F.lane] = f2bf(b2 * rstd * bf2f(gr[ro * 512 + h * 128 + 64 + F.lane]));
        }
        __syncthreads();
    }
}

__device__ __forceinline__ void sample_ret_item(const Frame& F, int it) {
    const float* state_ret = F.in(I_SRET); const bf16_t* qr = F.b16(WS_QR); const bf16_t* kr = F.b16(WS_KR); const bf16_t* vr = F.b16(WS_VR); const bf16_t* gr = F.b16(WS_GR); bf16_t* mixs = F.b16(WS_MIXS);
    LAS float* q = (LAS float*)F.lds; LAS float* k = q + 512; LAS float* v = k + 512; LAS float* red = v + 512; LAS float* qk = red + 2048; LAS float* o2 = qk + 16;
    {
        const int b = it >> 2, h = it & 3; const float lg = lg2g(h);
        { const int l = F.tid >> 7, d = F.tid & 127; const size_t ro = (size_t)(R_SAMP + b * 4 + l) * 512 + h * 128 + d; q[F.tid] = bf2f(qr[ro]); k[F.tid] = bf2f(kr[ro]); v[F.tid] = bf2f(vr[ro]); }
        __syncthreads();
        const int dv = F.tid & 127, dq = F.tid >> 7;
        const float* st = state_ret + (size_t)it * 16384; float* so = F.out + O_RETS + (size_t)it * 16384;
        const float g4 = __builtin_amdgcn_exp2f(4.0f * lg), gp0 = __builtin_amdgcn_exp2f(3.0f * lg), gp1 = __builtin_amdgcn_exp2f(2.0f * lg), gp2 = __builtin_amdgcn_exp2f(lg);
        const float v0 = v[dv] * gp0, v1 = v[128 + dv] * gp1, v2 = v[256 + dv] * gp2, v3 = v[384 + dv];
        float c0 = 0.f, c1 = 0.f, c2 = 0.f, c3 = 0.f;
        float sv[32];
#pragma unroll
        for (int i = 0; i < 32; ++i) sv[i] = st[(size_t)(dq * 32 + i) * 128 + dv];
#pragma unroll
        for (int i = 0; i < 32; ++i) {
            const int dk = dq * 32 + i; const float s = sv[i];
            c0 += q[dk] * s; c1 += q[128 + dk] * s; c2 += q[256 + dk] * s; c3 += q[384 + dk] * s;
            so[(size_t)dk * 128 + dv] = g4 * s + k[dk] * v0 + k[128 + dk] * v1 + k[256 + dk] * v2 + k[384 + dk] * v3;
        }
        red[(dq * 4 + 0) * 128 + dv] = c0; red[(dq * 4 + 1) * 128 + dv] = c1; red[(dq * 4 + 2) * 128 + dv] = c2; red[(dq * 4 + 3) * 128 + dv] = c3;
#pragma unroll
        for (int pp = 0; pp < 2; ++pp) { const int p_ = 2 * F.wave + pp, l = p_ >> 2, m = p_ & 3;
            float d = wave_sum(q[l * 128 + F.lane] * k[m * 128 + F.lane] + q[l * 128 + 64 + F.lane] * k[m * 128 + 64 + F.lane]);
            if (F.lane == 0) qk[p_] = m <= l ? d * __builtin_amdgcn_exp2f((float)(l - m) * lg) : 0.f; }
        __syncthreads();
        { const int l = F.tid >> 7; float o = 0.f;
          for (int a = 0; a < 4; ++a) o += red[(a * 4 + l) * 128 + dv];
          o *= __builtin_amdgcn_exp2f((float)(l + 1) * lg);
          for (int m = 0; m <= l; ++m) o += qk[l * 4 + m] * v[m * 128 + dv];
          o2[F.tid] = o; }
        __syncthreads();
        if (F.wave < 4) {
            const int l = F.wave; const float a = o2[l * 128 + F.lane], b2 = o2[l * 128 + 64 + F.lane];
            const float rstd = __builtin_amdgcn_rsqf(wave_sum(a * a + b2 * b2) * (1.0f / 128.0f) + EPS);
            const size_t ro = (size_t)(R_SAMP + b * 4 + l), so2 = (size_t)(b * 4 + l);
            mixs[so2 * 1536 + h * 128 + F.lane] = f2bf(a * rstd * bf2f(gr[ro * 512 + h * 128 + F.lane]));
            mixs[so2 * 1536 + h * 128 + 64 + F.lane] = f2bf(b2 * rstd * bf2f(gr[ro * 512 + h * 128 + 64 + F.lane]));
        }
        __syncthreads();
    }
}

__device__ __forceinline__ void attn_wave(const Frame& F_, int b, int h, int qrow0, int qpos0) {
    Frame F = F_; { int t_ = F_.tid; asm volatile("" : "+v"(t_)); F.tid = t_; F.lane = t_ & 63; }
    const int lr = F.lane & 15, g = F.lane >> 4;
    const bf16_t* Q = F.b16(WS_QP) + ((size_t)qrow0 * 4 + h) * 192;
    bf16x8 qf[2][6];
#pragma unroll
    for (int qg = 0; qg < 2; ++qg)
#pragma unroll
        for (int ks = 0; ks < 6; ++ks) qf[qg][ks] = *(const bf16x8*)(Q + (size_t)(16 * qg + lr) * 768 + 32 * ks + 8 * g);
    f32x4 o[2][8];
#pragma unroll
    for (int qg = 0; qg < 2; ++qg)
#pragma unroll
        for (int d = 0; d < 8; ++d) o[qg][d] = (f32x4){0.f, 0.f, 0.f, 0.f};
    float mrun[2] = {-INFINITY, -INFINITY}, lrun[2] = {0.f, 0.f};
    const int qpos[2] = {qpos0 + lr, qpos0 + 16 + lr};
    const int nkb = (qpos0 + 31) / 32 + 1;
    const bf16_t* Kb0 = F.b16(WS_KP) + h * 128; const bf16_t* Kbb = Kb0 + (size_t)b * TPP * 512;
    const bf16_t* Eb0 = F.b16(WS_KPE); const bf16_t* Ebb = Eb0 + (size_t)b * TPP * 64;
    const bf16_t* Vb0 = F.b16(WS_VT) + (size_t)h * 128 * TPP; const bf16_t* Vbb = Vb0 + (size_t)b * 4 * 128 * TPP;
#pragma unroll 1
    for (int kb = 0; kb < nkb; ++kb) {
        const int k0 = 32 * kb;
        f32x4 s[2][2];
#pragma unroll
        for (int kg = 0; kg < 2; ++kg)
#pragma unroll
            for (int qg = 0; qg < 2; ++qg) s[kg][qg] = (f32x4){0.f, 0.f, 0.f, 0.f};
#pragma unroll
        for (int ks = 0; ks < 6; ++ks)
#pragma unroll
            for (int kg = 0; kg < 2; ++kg) {
                const bf16_t* Kb = (kb == 0 && kg == 0) ? Kb0 : Kbb; const bf16_t* Eb = (kb == 0 && kg == 0) ? Eb0 : Ebb;
                const bf16x8 kf = ks < 4 ? *(const bf16x8*)(Kb + (size_t)(k0 + 16 * kg + lr) * 512 + 32 * ks + 8 * g) : *(const bf16x8*)(Eb + (size_t)(k0 + 16 * kg + lr) * 64 + 32 * (ks - 4) + 8 * g);
#pragma unroll
                for (int qg = 0; qg < 2; ++qg) s[kg][qg] = mfma16(kf, qf[qg][ks], s[kg][qg]);
            }
        if (k0 + 31 > qpos0) {
#pragma unroll
            for (int kg = 0; kg < 2; ++kg)
#pragma unroll
                for (int qg = 0; qg < 2; ++qg)
#pragma unroll
                    for (int j = 0; j < 4; ++j) if (k0 + 16 * kg + 4 * g + j > qpos[qg]) s[kg][qg][j] = -INFINITY;
        }
        bf16x8 pf[2];
#pragma unroll
        for (int qg = 0; qg < 2; ++qg) {
            float mx = fmaxf(fmaxf(fmaxf(s[0][qg][0], s[0][qg][1]), fmaxf(s[0][qg][2], s[0][qg][3])), fmaxf(fmaxf(s[1][qg][0], s[1][qg][1]), fmaxf(s[1][qg][2], s[1][qg][3])));
            mx = fmaxf(mx, __shfl_xor(mx, 16)); mx = fmaxf(mx, __shfl_xor(mx, 32));
            const float mn = fmaxf(mrun[qg], mx), al = __builtin_amdgcn_exp2f(mrun[qg] - mn);
            float pv[8]; float rs = 0.f;
#pragma unroll
            for (int j = 0; j < 4; ++j) { pv[j] = __builtin_amdgcn_exp2f(s[0][qg][j] - mn); pv[4 + j] = __builtin_amdgcn_exp2f(s[1][qg][j] - mn); rs += pv[j] + pv[4 + j]; }
            rs += __shfl_xor(rs, 16); rs += __shfl_xor(rs, 32);
            lrun[qg] = lrun[qg] * al + rs; mrun[qg] = mn;
#pragma unroll
            for (int d = 0; d < 8; ++d) o[qg][d] *= al;
            u32x4 pk = (u32x4){cvt_pk_bf16(pv[0], pv[1]), cvt_pk_bf16(pv[2], pv[3]), cvt_pk_bf16(pv[4], pv[5]), cvt_pk_bf16(pv[6], pv[7])};
            pf[qg] = __builtin_bit_cast(bf16x8, pk);
        }
#pragma unroll
        for (int d = 0; d < 8; ++d) {
            const size_t vo = (size_t)(16 * d + lr) * TPP + k0 + 4 * g;
            const u32x2 lo = *(const u32x2*)((kb == 0 ? Vb0 : Vbb) + vo), hi = *(const u32x2*)(Vbb + vo + 16);
            const bf16x8 vf = __builtin_bit_cast(bf16x8, (u32x4){lo[0], lo[1], hi[0], hi[1]});
#pragma unroll
            for (int qg = 0; qg < 2; ++qg) o[qg][d] = mfma16(vf, pf[qg], o[qg][d]);
        }
    }
    bf16_t* mixa = F.b16(WS_MIXA);
#pragma unroll
    for (int qg = 0; qg < 2; ++qg) {
        const float il = 1.0f / lrun[qg]; bf16_t* d0 = mixa + (size_t)(qrow0 + 16 * qg + lr) * 1024 + 512 + h * 128 + 4 * g;
#pragma unroll
        for (int d = 0; d < 8; ++d) { const f32x4 v = o[qg][d] * il; *(u32x2*)(d0 + 16 * d) = (u32x2){cvt_pk_bf16(v[0], v[1]), cvt_pk_bf16(v[2], v[3])}; }
    }
}


constexpr int AT_KN = 0, AT_KR = 16384, AT_VT = 24576, AT_BUF = 40960;
__device__ __forceinline__ void attn_unit(const Frame& F_, int j) {
    Frame F = F_; { int t_ = F_.tid; asm volatile("" : "+v"(t_)); F.tid = t_; F.lane = t_ & 63; }
    const int bh = j & 15, b = bh >> 2, h = bh & 3, pp = j >> 4, lr = F.lane & 15, g = F.lane >> 4, w = F.wave;
    const int blk = (w >> 2) ? 31 - pp : pp, t0 = blk * 128 + 32 * (w & 3), qrow0 = b * 4096 + t0, qpos0 = 16 + t0;
    const int ntile = (143 + 128 * (31 - pp)) / 64 + 1;
    const char* K0 = (const char*)(F.b16(WS_KP) + h * 128); const char* Kb = K0 + (size_t)b * TPP * 1024;
    const char* E0 = (const char*)F.b16(WS_KPE); const char* Eb = E0 + (size_t)b * TPP * 128;
    const char* V0 = (const char*)(F.b16(WS_VT) + (size_t)h * 128 * TPP); const char* Vb = V0 + (size_t)b * 4 * 128 * TPP * 2;
    bf16x8 qf[2][6];
    { const bf16_t* Q = F.b16(WS_QP) + ((size_t)qrow0 * 4 + h) * 192;
#pragma unroll
      for (int qg = 0; qg < 2; ++qg)
#pragma unroll
          for (int ks = 0; ks < 6; ++ks) qf[qg][ks] = *(const bf16x8*)(Q + (size_t)(16 * qg + lr) * 768 + 32 * ks + 8 * g); }
    f32x4 o[2][8];
#pragma unroll
    for (int qg = 0; qg < 2; ++qg)
#pragma unroll
        for (int d = 0; d < 8; ++d) o[qg][d] = (f32x4){0.f, 0.f, 0.f, 0.f};
    float mrun[2] = {0.f, 0.f}, lrun[2] = {0.f, 0.f};
    const int qpos[2] = {qpos0 + lr, qpos0 + 16 + lr};
    unsigned so[5]; int srow[5];
#pragma unroll
    for (int i = 0; i < 2; ++i) { const int row = 4 * (2 * w + i) + (F.lane >> 4), c = (F.lane & 15) ^ (row & 15); so[i] = (unsigned)(row * 1024 + c * 16); srow[i] = row; }
    { const int row = 8 * w + (F.lane >> 3), c = (F.lane & 7) ^ ((row >> 1) & 7); so[2] = (unsigned)(row * 128 + c * 16); srow[2] = row; }
#pragma unroll
    for (int i = 0; i < 2; ++i) { const int row = 8 * (2 * w + i) + (F.lane >> 3), c = (F.lane & 7) ^ ((row >> 1) & 7); so[3 + i] = (unsigned)(row * (TPP * 2) + c * 16); srow[3 + i] = c * 8; }
    int koff[4], roff[2], voff[2][2];
#pragma unroll
    for (int ks = 0; ks < 4; ++ks) koff[ks] = AT_KN + lr * 256 + 16 * ((4 * ks + g) ^ lr);
#pragma unroll
    for (int k2 = 0; k2 < 2; ++k2) roff[k2] = AT_KR + lr * 128 + 16 * ((4 * k2 + g) ^ (lr >> 1));
#pragma unroll
    for (int sb = 0; sb < 2; ++sb)
#pragma unroll
        for (int hh = 0; hh < 2; ++hh) voff[sb][hh] = AT_VT + lr * 128 + 16 * ((4 * sb + (g >> 1) + 2 * hh) ^ (lr >> 1)) + 8 * (g & 1);
#define AT_DMA(t, buf) do { const int t_ = (t); LAS unsigned char* B_ = F.lds + (buf) * AT_BUF; const size_t kb_ = (size_t)t_ * 64; \
        _Pragma("unroll") for (int i_ = 0; i_ < 2; ++i_) __builtin_amdgcn_global_load_lds((const unsigned*)(((t_ == 0 && srow[i_] < 16) ? K0 : Kb) + kb_ * 1024 + so[i_]), (LAS unsigned*)(B_ + AT_KN + 1024 * (2 * w + i_)), 16, 0, 0); \
        __builtin_amdgcn_global_load_lds((const unsigned*)(((t_ == 0 && srow[2] < 16) ? E0 : Eb) + kb_ * 128 + so[2]), (LAS unsigned*)(B_ + AT_KR + 1024 * w), 16, 0, 0); \
        _Pragma("unroll") for (int i_ = 0; i_ < 2; ++i_) __builtin_amdgcn_global_load_lds((const unsigned*)(((t_ == 0 && srow[3 + i_] < 16) ? V0 : Vb) + kb_ * 2 + so[3 + i_]), (LAS unsigned*)(B_ + AT_VT + 1024 * (2 * w + i_)), 16, 0, 0); } while (0)
    asm volatile("s_waitcnt vmcnt(0)" ::: "memory");
    AT_DMA(0, 0);
    if (ntile > 1) { AT_DMA(1, 1); asm volatile("s_waitcnt vmcnt(5)" ::: "memory"); } else asm volatile("s_waitcnt vmcnt(0)" ::: "memory");
    __builtin_amdgcn_s_barrier();
    int bcur = 0;
#pragma unroll 1
    for (int t = 0; t < ntile; ++t) {
        if (t + 2 < ntile) { const int bn = bcur >= 1 ? bcur - 1 : 2; AT_DMA(t + 2, bn); }
        if (64 * t <= qpos0 + 31) {
            const LAS unsigned char* Bt = F.lds + bcur * AT_BUF;
#pragma unroll 1
            for (int sub = 0; sub < 2; ++sub) {
                const int k0 = 64 * t + 32 * sub;
                if (k0 > qpos0 + 31) break;
                const LAS unsigned char* Kt = Bt + sub * 32 * 256; const LAS unsigned char* Rt = Bt + sub * 32 * 128;
                bf16x8 kf[2][6];
#pragma unroll
                for (int kg = 0; kg < 2; ++kg) {
#pragma unroll
                    for (int ks = 0; ks < 4; ++ks) kf[kg][ks] = *(const LAS bf16x8*)(Kt + kg * 4096 + koff[ks]);
#pragma unroll
                    for (int k2 = 0; k2 < 2; ++k2) kf[kg][4 + k2] = *(const LAS bf16x8*)(Rt + kg * 2048 + roff[k2]);
                }
                f32x4 s[2][2];
#pragma unroll
                for (int kg = 0; kg < 2; ++kg) { s[kg][0] = (f32x4){-mrun[0], -mrun[0], -mrun[0], -mrun[0]}; s[kg][1] = (f32x4){-mrun[1], -mrun[1], -mrun[1], -mrun[1]}; }
                __builtin_amdgcn_sched_barrier(0);
                asm volatile("s_waitcnt lgkmcnt(0)" ::: "memory");
                __builtin_amdgcn_sched_barrier(0);
#pragma unroll
                for (int ks = 0; ks < 6; ++ks)
#pragma unroll
                    for (int kg = 0; kg < 2; ++kg) { s[kg][0] = mfma16(kf[kg][ks], qf[0][ks], s[kg][0]); s[kg][1] = mfma16(kf[kg][ks], qf[1][ks], s[kg][1]); }
                u32x2 vlo[8], vhi[8];
#pragma unroll
                for (int d = 0; d < 8; ++d) { vlo[d] = *(const LAS u32x2*)(Bt + d * 2048 + voff[sub][0]); vhi[d] = *(const LAS u32x2*)(Bt + d * 2048 + voff[sub][1]); }
                __builtin_amdgcn_sched_barrier(0);
                if (k0 + 31 > qpos0) {
#pragma unroll
                    for (int kg = 0; kg < 2; ++kg)
#pragma unroll
                        for (int qg = 0; qg < 2; ++qg)
#pragma unroll
                            for (int jj = 0; jj < 4; ++jj) if (k0 + 16 * kg + 4 * g + jj > qpos[qg]) s[kg][qg][jj] = -INFINITY;
                }
                float mx0 = fmaxf(fmaxf(fmaxf(s[0][0][0], s[0][0][1]), fmaxf(s[0][0][2], s[0][0][3])), fmaxf(fmaxf(s[1][0][0], s[1][0][1]), fmaxf(s[1][0][2], s[1][0][3])));
                float mx1 = fmaxf(fmaxf(fmaxf(s[0][1][0], s[0][1][1]), fmaxf(s[0][1][2], s[0][1][3])), fmaxf(fmaxf(s[1][1][0], s[1][1][1]), fmaxf(s[1][1][2], s[1][1][3])));
                const bool first = (k0 == 0);
                if (first || __any(fmaxf(mx0, mx1) > 8.0f)) {
                    mx0 = fmaxf(mx0, __shfl_xor(mx0, 16)); mx0 = fmaxf(mx0, __shfl_xor(mx0, 32)); mx1 = fmaxf(mx1, __shfl_xor(mx1, 16)); mx1 = fmaxf(mx1, __shfl_xor(mx1, 32));
                    const float d0 = first ? mx0 : fmaxf(mx0, 0.f), d1 = first ? mx1 : fmaxf(mx1, 0.f);
                    const float a0 = first ? 1.0f : __builtin_amdgcn_exp2f(-d0), a1 = first ? 1.0f : __builtin_amdgcn_exp2f(-d1);
                    mrun[0] += d0; mrun[1] += d1; lrun[0] *= a0; lrun[1] *= a1;
#pragma unroll
                    for (int d = 0; d < 8; ++d) { o[0][d] *= a0; o[1][d] *= a1; }
#pragma unroll
                    for (int kg = 0; kg < 2; ++kg) { s[kg][0] -= d0; s[kg][1] -= d1; }
                }
                bf16x8 pf[2];
#pragma unroll
                for (int qg = 0; qg < 2; ++qg) {
                    float pv[8]; float rs = 0.f;
#pragma unroll
                    for (int jj = 0; jj < 4; ++jj) { pv[jj] = __builtin_amdgcn_exp2f(s[0][qg][jj]); pv[4 + jj] = __builtin_amdgcn_exp2f(s[1][qg][jj]); rs += pv[jj] + pv[4 + jj]; }
                    lrun[qg] += rs;
                    pf[qg] = __builtin_bit_cast(bf16x8, (u32x4){cvt_pk_bf16(pv[0], pv[1]), cvt_pk_bf16(pv[2], pv[3]), cvt_pk_bf16(pv[4], pv[5]), cvt_pk_bf16(pv[6], pv[7])});
                }
                __builtin_amdgcn_sched_barrier(0);
                asm volatile("s_waitcnt lgkmcnt(0)" ::: "memory");
                __builtin_amdgcn_sched_barrier(0);
#pragma unroll
                for (int d = 0; d < 8; ++d) {
                    const bf16x8 vf = __builtin_bit_cast(bf16x8, (u32x4){vlo[d][0], vlo[d][1], vhi[d][0], vhi[d][1]});
                    o[0][d] = mfma16(vf, pf[0], o[0][d]); o[1][d] = mfma16(vf, pf[1], o[1][d]);
                }
            }
        }
        if (t + 2 < ntile) asm volatile("s_waitcnt vmcnt(5)" ::: "memory"); else asm volatile("s_waitcnt vmcnt(0)" ::: "memory");
        __builtin_amdgcn_s_barrier();
        bcur = bcur == 2 ? 0 : bcur + 1;
    }
#undef AT_DMA
    bf16_t* mixa = F.b16(WS_MIXA);
#pragma unroll
    for (int qg = 0; qg < 2; ++qg) {
        float lt = lrun[qg]; lt += __shfl_xor(lt, 16); lt += __shfl_xor(lt, 32);
        const float il = 1.0f / lt; bf16_t* d0 = mixa + (size_t)(qrow0 + 16 * qg + lr) * 1024 + 512 + h * 128 + 4 * g;
#pragma unroll
        for (int d = 0; d < 8; ++d) { const f32x4 v = o[qg][d] * il; *(u32x2*)(d0 + 16 * d) = (u32x2){cvt_pk_bf16(v[0], v[1]), cvt_pk_bf16(v[2], v[3])}; }
    }
}

constexpr int RU_K = 0, RU_V = 32768, RU_S = 65536;
__device__ __forceinline__ void ret_unit(const Frame& F_, int it) {
    Frame F = F_; { int t_ = F_.tid; asm volatile("" : "+v"(t_)); F.tid = t_; F.lane = t_ & 63; }
    const int bh = it >> 5, c = it & 31, b = bh >> 2, h = bh & 3, t0 = c * 128, R0 = b * 4096 + t0, w = F.wave, l0 = 16 * w;
    const int lr = F.lane & 15, g = F.lane >> 4; const float lg = lg2g(h);
    if (F.tid == 0) { unsigned* cr = (unsigned*)(F.ws + WS_CTL + 20480) + 16 * bh; unsigned sp = 0;
        while (__hip_atomic_load(cr, __ATOMIC_RELAXED, __HIP_MEMORY_SCOPE_AGENT) < 8u) { __builtin_amdgcn_s_sleep(2); if (++sp > (1u << 22)) { __hip_atomic_store((unsigned*)(F.ws + WS_CTL) + XB_TMO, 1u, __ATOMIC_RELAXED, __HIP_MEMORY_SCOPE_AGENT); break; } }
        __builtin_amdgcn_fence(__ATOMIC_ACQUIRE, "agent"); asm volatile("s_waitcnt vmcnt(0)" ::: "memory"); }
    __syncthreads();
    const char* ksrc = (const char*)(F.b16(WS_KR) + (size_t)R0 * 512 + h * 128);
    const char* vsrc = (const char*)(F.b16(WS_VTR) + (size_t)bh * 128 * 4096 + t0);
    const char* ssrc = (const char*)(F.b16(WS_SB) + (size_t)it * 16384);
#pragma unroll
    for (int i = 0; i < 4; ++i) {
        const int j = 4 * w + i, row = 4 * j + (F.lane >> 4), cs = ((F.lane & 15) ^ (row & 15)) * 16;
        __builtin_amdgcn_global_load_lds((const unsigned*)(ksrc + (size_t)row * 1024 + cs), (LAS unsigned*)(F.lds + RU_K + 1024 * j), 16, 0, 0);
        __builtin_amdgcn_global_load_lds((const unsigned*)(vsrc + (size_t)row * 8192 + cs), (LAS unsigned*)(F.lds + RU_V + 1024 * j), 16, 0, 0);
        __builtin_amdgcn_global_load_lds((const unsigned*)(ssrc + (size_t)row * 256 + cs), (LAS unsigned*)(F.lds + RU_S + 1024 * j), 16, 0, 0);
    }
    bf16x8 qf[4];
#pragma unroll
    for (int ks = 0; ks < 4; ++ks) qf[ks] = *(const bf16x8*)(F.b16(WS_QR) + (size_t)(R0 + l0 + lr) * 512 + h * 128 + 32 * ks + 8 * g);
    int koff[4];
#pragma unroll
    for (int ks = 0; ks < 4; ++ks) koff[ks] = lr * 256 + 16 * ((4 * ks + g) ^ lr);
    asm volatile("s_waitcnt vmcnt(0)" ::: "memory");
    __syncthreads();
    f32x4 xa[8], ia[8];
#pragma unroll
    for (int d = 0; d < 8; ++d) { xa[d] = (f32x4){0.f, 0.f, 0.f, 0.f}; ia[d] = (f32x4){0.f, 0.f, 0.f, 0.f}; }
#pragma unroll
    for (int d = 0; d < 8; ++d)
#pragma unroll
        for (int ks = 0; ks < 4; ++ks) { const bf16x8 sf = *(const LAS bf16x8*)(F.lds + RU_S + d * 4096 + koff[ks]); xa[d] = mfma16(sf, qf[ks], xa[d]); }
    const int li = l0 + lr, nmb = (l0 + 15) / 32 + 1;
#pragma unroll 1
    for (int mb = 0; mb < nmb; ++mb) {
        f32x4 s[2] = {(f32x4){0.f, 0.f, 0.f, 0.f}, (f32x4){0.f, 0.f, 0.f, 0.f}};
#pragma unroll
        for (int kg = 0; kg < 2; ++kg)
#pragma unroll
            for (int ks = 0; ks < 4; ++ks) { const bf16x8 kf = *(const LAS bf16x8*)(F.lds + RU_K + (32 * mb + 16 * kg) * 256 + koff[ks]); s[kg] = mfma16(kf, qf[ks], s[kg]); }
        float pv[8];
#pragma unroll
        for (int kg = 0; kg < 2; ++kg)
#pragma unroll
            for (int j = 0; j < 4; ++j) { const int mi = 32 * mb + 16 * kg + 4 * g + j; pv[4 * kg + j] = li >= mi ? s[kg][j] * __builtin_amdgcn_exp2f((float)(li - mi) * lg) : 0.f; }
        const bf16x8 pf = __builtin_bit_cast(bf16x8, (u32x4){cvt_pk_bf16(pv[0], pv[1]), cvt_pk_bf16(pv[2], pv[3]), cvt_pk_bf16(pv[4], pv[5]), cvt_pk_bf16(pv[6], pv[7])});
        const int vlo = lr * 256 + 16 * ((4 * mb + (g >> 1)) ^ lr) + 8 * (g & 1), vhi = lr * 256 + 16 * ((4 * mb + (g >> 1) + 2) ^ lr) + 8 * (g & 1);
#pragma unroll
        for (int d = 0; d < 8; ++d) {
            const u32x2 lo = *(const LAS u32x2*)(F.lds + RU_V + d * 4096 + vlo), hi = *(const LAS u32x2*)(F.lds + RU_V + d * 4096 + vhi);
            ia[d] = mfma16(__builtin_bit_cast(bf16x8, (u32x4){lo[0], lo[1], hi[0], hi[1]}), pf, ia[d]);
        }
    }
    const float xs = __builtin_amdgcn_exp2f((float)(li + 1) * lg); float ss = 0.f;
#pragma unroll
    for (int d = 0; d < 8; ++d) { ia[d] += xa[d] * xs; ss += ia[d][0] * ia[d][0] + ia[d][1] * ia[d][1] + ia[d][2] * ia[d][2] + ia[d][3] * ia[d][3]; }
    ss += __shfl_xor(ss, 16); ss += __shfl_xor(ss, 32);
    const float rstd = __builtin_amdgcn_rsqf(ss * (1.0f / 128.0f) + EPS);
    const bf16_t* gp = F.b16(WS_GR) + (size_t)(R0 + li) * 512 + h * 128 + 4 * g; bf16_t* op = F.b16(WS_MIXA) + (size_t)(R0 + li) * 1024 + h * 128 + 4 * g;
#pragma unroll
    for (int d = 0; d < 8; ++d) {
        const u32x2 gg = *(const u32x2*)(gp + 16 * d);
        const float g0 = __uint_as_float(gg[0] << 16), g1 = __uint_as_float(gg[0] & 0xffff0000u), g2 = __uint_as_float(gg[1] << 16), g3 = __uint_as_float(gg[1] & 0xffff0000u);
        *(u32x2*)(op + 16 * d) = (u32x2){cvt_pk_bf16(ia[d][0] * rstd * g0, ia[d][1] * rstd * g1), cvt_pk_bf16(ia[d][2] * rstd * g2, ia[d][3] * rstd * g3)};
    }
    __syncthreads();
}

__device__ __forceinline__ void combine_item(const Frame& F, int b);
constexpr int DW_PITCH = 544;
constexpr int DW_BYTES = 32 * DW_PITCH;
__device__ __forceinline__ void decode_stream(const Frame& F_, unsigned* qc, volatile LAS unsigned* misc) {
    Frame F = F_; { int t_ = F_.tid; asm volatile("" : "+v"(t_)); F.tid = t_; F.lane = t_ & 63; }
    constexpr int NIT = 128 * NSPLIT;
    const int wu = __builtin_amdgcn_readfirstlane(F.wave), w = wu;
    LAS unsigned char* QL = F.lds + 8 * DW_BYTES; LAS unsigned char* T = F.lds + w * DW_BYTES;
    if (F.tid == 0) { misc[2] = __hip_atomic_fetch_add(qc, 1u, __ATOMIC_RELAXED, __HIP_MEMORY_SCOPE_AGENT); misc[3] = __hip_atomic_fetch_add(qc, 1u, __ATOMIC_RELAXED, __HIP_MEMORY_SCOPE_AGENT); }
    __syncthreads();
    int it = __builtin_amdgcn_readfirstlane((int)misc[2]), itn = __builtin_amdgcn_readfirstlane((int)misc[3]);
    __syncthreads();
    if (it >= NIT) return;
#define DC_PIDX(i_) (((i_) / NSPLIT) * NPG + ((i_) % NSPLIT) * (NPG / NSPLIT) + wu)
#define DC_ISSUE(ck_, cp_, h_) do { _Pragma("unroll") for (int i = 0; i < 16; ++i) ckr[i] = *(const f32x4*)((ck_) + (size_t)(16 * (h_) + i) * 256); \
        _Pragma("unroll") for (int k2 = 0; k2 < 2; ++k2) { per[2 * k2] = *(const f32x4*)((cp_) + (size_t)(16 * (h_)) * 64 + 32 * k2); per[2 * k2 + 1] = *(const f32x4*)((cp_) + (size_t)(16 * (h_)) * 64 + 32 * k2 + 4); } } while (0)
    f32x4 ckr[16], per[4];
    int page = ((const int*)F.in(I_PT))[DC_PIDX(it)];
    { const int lr = F.lane & 15, g = F.lane >> 4; const float* ck = F.in(I_CKV) + (size_t)page * PGSZ * 256 + F.lane * 4; const float* cp = F.in(I_CPE) + (size_t)page * PGSZ * 64 + lr * 64 + 8 * g; DC_ISSUE(ck, cp, 0); }
#pragma unroll 1
    for (;;) {
    { int t_ = F.tid; asm volatile("" : "+v"(t_)); F.tid = t_; F.lane = t_ & 63; }
    const int lr = F.lane & 15, g = F.lane >> 4;
    const int b = it / NSPLIT;
    const float* ck = F.in(I_CKV) + (size_t)page * PGSZ * 256 + F.lane * 4; const float* cp = F.in(I_CPE) + (size_t)page * PGSZ * 64 + lr * 64 + 8 * g;
    int pagen = 0; if (itn < NIT) pagen = ((const int*)F.in(I_PT))[DC_PIDX(itn)];
    unsigned nx2 = 0u; if (F.tid == 0) nx2 = __hip_atomic_fetch_add(qc, 1u, __ATOMIC_RELAXED, __HIP_MEMORY_SCOPE_AGENT);
    { const bf16_t* ql = F.b16(WS_QSLAT) + ((size_t)b * 16 + lr) * 256; const bf16_t* qp = F.b16(WS_QSPE) + ((size_t)b * 16 + lr) * 64;
      *(LAS bf16x8*)(QL + w * 1024 + F.lane * 16) = *(const bf16x8*)(ql + 32 * w + 8 * g);
      if (w < 2) *(LAS bf16x8*)(QL + (8 + w) * 1024 + F.lane * 16) = *(const bf16x8*)(qp + 32 * w + 8 * g); }
    if (F.tid == 0) misc[2] = nx2;
    __syncthreads();
    const int itnn = __builtin_amdgcn_readfirstlane((int)misc[2]);
    f32x4 o[16];
#pragma unroll
    for (int cb = 0; cb < 16; ++cb) o[cb] = (f32x4){0.f, 0.f, 0.f, 0.f};
    float mrun = 0.f, lrun = 0.f;
#pragma unroll 1
    for (int hp = 0; hp < 4; ++hp) {
        f32x4 s[2] = {(f32x4){-mrun, -mrun, -mrun, -mrun}, (f32x4){-mrun, -mrun, -mrun, -mrun}};
#pragma unroll
        for (int hh = 0; hh < 2; ++hh) {
            const int h = 2 * hp + hh;
#pragma unroll
            for (int i = 0; i < 16; ++i) *(LAS u32x2*)(T + (16 * hh + i) * DW_PITCH + F.lane * 8) = (u32x2){cvt_pk_bf16(ckr[i][0], ckr[i][1]), cvt_pk_bf16(ckr[i][2], ckr[i][3])};
#pragma unroll
            for (int k2 = 0; k2 < 2; ++k2) {
                const bf16x8 pef = __builtin_bit_cast(bf16x8, (u32x4){cvt_pk_bf16(per[2 * k2][0], per[2 * k2][1]), cvt_pk_bf16(per[2 * k2][2], per[2 * k2][3]), cvt_pk_bf16(per[2 * k2 + 1][0], per[2 * k2 + 1][1]), cvt_pk_bf16(per[2 * k2 + 1][2], per[2 * k2 + 1][3])});
                s[hh] = mfma16(pef, *(const LAS bf16x8*)(QL + (8 + k2) * 1024 + F.lane * 16), s[hh]); }
            if (h + 1 < 8) DC_ISSUE(ck, cp, h + 1); else if (itn < NIT) { const float* ckn = F.in(I_CKV) + (size_t)pagen * PGSZ * 256 + F.lane * 4; const float* cpn = F.in(I_CPE) + (size_t)pagen * PGSZ * 64 + lr * 64 + 8 * g; DC_ISSUE(ckn, cpn, 0); }
        }
#pragma unroll
        for (int kb = 0; kb < 2; ++kb) {
            bf16x8 kf[2][4], qf[4];
#pragma unroll
            for (int k4 = 0; k4 < 4; ++k4) qf[k4] = *(const LAS bf16x8*)(QL + (4 * kb + k4) * 1024 + F.lane * 16);
#pragma unroll
            for (int kg = 0; kg < 2; ++kg)
#pragma unroll
                for (int k4 = 0; k4 < 4; ++k4) kf[kg][k4] = *(const LAS bf16x8*)(T + (16 * kg + lr) * DW_PITCH + 64 * (4 * kb + k4) + 16 * g);
            __builtin_amdgcn_sched_barrier(0);
            asm volatile("s_waitcnt lgkmcnt(0)" ::: "memory");
            __builtin_amdgcn_sched_barrier(0);
#pragma unroll
            for (int k4 = 0; k4 < 4; ++k4) { s[0] = mfma16(kf[0][k4], qf[k4], s[0]); s[1] = mfma16(kf[1][k4], qf[k4], s[1]); }
        }
        float mx = fmaxf(fmaxf(fmaxf(s[0][0], s[0][1]), fmaxf(s[0][2], s[0][3])), fmaxf(fmaxf(s[1][0], s[1][1]), fmaxf(s[1][2], s[1][3])));
        const bool first = (hp == 0);
        if (first || __any(mx > 8.0f)) {
            mx = fmaxf(mx, __shfl_xor(mx, 16)); mx = fmaxf(mx, __shfl_xor(mx, 32));
            const float d = first ? mx : fmaxf(mx, 0.f), al = first ? 1.0f : __builtin_amdgcn_exp2f(-d);
            mrun += d; lrun *= al;
#pragma unroll
            for (int cb = 0; cb < 16; ++cb) o[cb] *= al;
            s[0] -= d; s[1] -= d;
        }
        float pv[8]; float rs = 0.f;
#pragma unroll
        for (int j = 0; j < 4; ++j) { pv[j] = __builtin_amdgcn_exp2f(s[0][j]); pv[4 + j] = __builtin_amdgcn_exp2f(s[1][j]); rs += pv[j] + pv[4 + j]; }
        lrun += rs;
        const bf16x8 pf = __builtin_bit_cast(bf16x8, (u32x4){cvt_pk_bf16(pv[0], pv[1]), cvt_pk_bf16(pv[2], pv[3]), cvt_pk_bf16(pv[4], pv[5]), cvt_pk_bf16(pv[6], pv[7])});
        const LAS unsigned char* a0 = T + (4 * g + (lr >> 2)) * DW_PITCH + 4 * (lr & 3) * 2;
#pragma unroll
        for (int ch = 0; ch < 2; ++ch) {
            s16x4 lo[8], hi[8];
#pragma unroll
            for (int c8 = 0; c8 < 8; ++c8) {
                lo[c8] = __builtin_bit_cast(s16x4, __builtin_amdgcn_ds_read_tr16_b64_v4i16((LAS s16x4*)(a0 + 32 * (8 * ch + c8))));
                hi[c8] = __builtin_bit_cast(s16x4, __builtin_amdgcn_ds_read_tr16_b64_v4i16((LAS s16x4*)(a0 + 16 * DW_PITCH + 32 * (8 * ch + c8)))); }
            __builtin_amdgcn_sched_barrier(0);
            asm volatile("s_waitcnt lgkmcnt(0)" ::: "memory");
            __builtin_amdgcn_sched_barrier(0);
#pragma unroll
            for (int c8 = 0; c8 < 8; ++c8) { const bf16x8 vf = (bf16x8){lo[c8][0], lo[c8][1], lo[c8][2], lo[c8][3], hi[c8][0], hi[c8][1], hi[c8][2], hi[c8][3]}; o[8 * ch + c8] = mfma16(vf, pf, o[8 * ch + c8]); }
        }
    }
    lrun += __shfl_xor(lrun, 16); lrun += __shfl_xor(lrun, 32);
    __syncthreads();
    LAS f32x4* OP = (LAS f32x4*)F.lds; LAS f32x2* ML = (LAS f32x2*)(F.lds + 131072);
#pragma unroll
    for (int cb = 0; cb < 16; ++cb) OP[(w * 16 + cb) * 64 + F.lane] = o[cb];
    if (g == 0) ML[w * 16 + lr] = (f32x2){mrun, lrun};
    __syncthreads();
    float M = -INFINITY; float mj[8], lj[8];
#pragma unroll
    for (int j = 0; j < 8; ++j) { const f32x2 t = ML[j * 16 + lr]; mj[j] = t[0]; lj[j] = t[1]; M = fmaxf(M, t[0]); }
    float L = 0.f; f32x4 r0 = (f32x4){0.f, 0.f, 0.f, 0.f}, r1 = (f32x4){0.f, 0.f, 0.f, 0.f};
#pragma unroll
    for (int j = 0; j < 8; ++j) { const float wj = __builtin_amdgcn_exp2f(mj[j] - M); L += wj * lj[j]; r0 += OP[(j * 16 + 2 * w) * 64 + F.lane] * wj; r1 += OP[(j * 16 + 2 * w + 1) * 64 + F.lane] * wj; }
    { unsigned long long* po = (unsigned long long*)(F.f32(WS_PARTO) + ((size_t)it * 16 + lr) * 256 + 32 * w + 4 * g);
      __hip_atomic_store(po, ((unsigned long long)__float_as_uint(r0[1]) << 32) | __float_as_uint(r0[0]), __ATOMIC_RELAXED, __HIP_MEMORY_SCOPE_AGENT);
      __hip_atomic_store(po + 1, ((unsigned long long)__float_as_uint(r0[3]) << 32) | __float_as_uint(r0[2]), __ATOMIC_RELAXED, __HIP_MEMORY_SCOPE_AGENT);
      __hip_atomic_store(po + 8, ((unsigned long long)__float_as_uint(r1[1]) << 32) | __float_as_uint(r1[0]), __ATOMIC_RELAXED, __HIP_MEMORY_SCOPE_AGENT);
      __hip_atomic_store(po + 9, ((unsigned long long)__float_as_uint(r1[3]) << 32) | __float_as_uint(r1[2]), __ATOMIC_RELAXED, __HIP_MEMORY_SCOPE_AGENT);
      if (w == 0 && g == 0) __hip_atomic_store((unsigned long long*)(F.f32(WS_PARTML) + ((size_t)it * 16 + lr) * 2), ((unsigned long long)__float_as_uint(L) << 32) | __float_as_uint(M), __ATOMIC_RELAXED, __HIP_MEMORY_SCOPE_AGENT); }
    asm volatile("s_waitcnt vmcnt(0)" ::: "memory");
    __syncthreads();
    if (F.tid == 64) __hip_atomic_fetch_add((unsigned*)(F.ws + WS_CTL + 53248) + 16 * b, 1u, __ATOMIC_RELAXED, __HIP_MEMORY_SCOPE_AGENT);
    __syncthreads();
    if (itn >= NIT) break;
    it = itn; itn = itnn; page = pagen;
    }
#undef DC_ISSUE
#undef DC_PIDX
}

__device__ __forceinline__ void combine_item(const Frame& F_, int b) {
    Frame F = F_; { int t_ = F_.tid; asm volatile("" : "+v"(t_)); F.tid = t_; F.lane = t_ & 63; }
    LAS float* ss = (LAS float*)F.lds;
    const bf16_t* qlat = F.b16(WS_QSLAT) + (size_t)b * 16 * 256; const bf16_t* qpe = F.b16(WS_QSPE) + (size_t)b * 16 * 64;
    const float* ckv = F.out + O_KVS + (size_t)b * 4 * 256; const float* kpe = F.out + O_KRS + (size_t)b * 4 * 64;
    {
        const int pr = F.tid >> 3, sub = F.tid & 7, q = pr >> 2, kl = pr & 3, lq = q >> 2; float s = 0.f;
        if (kl <= lq) {
#pragma unroll 8
            for (int c = 0; c < 32; ++c) s += bf2f(qlat[q * 256 + sub * 32 + c]) * ckv[kl * 256 + sub * 32 + c];
#pragma unroll
            for (int c = 0; c < 8; ++c) s += bf2f(qpe[q * 64 + sub * 8 + c]) * kpe[kl * 64 + sub * 8 + c]; }
        s += __shfl_xor(s, 1); s += __shfl_xor(s, 2); s += __shfl_xor(s, 4);
        if (sub == 0) ss[pr] = kl <= lq ? s : -INFINITY;
    }
    __syncthreads();
    const int q = F.tid >> 5, c0 = (F.tid & 31) * 8, lq = q >> 2, h = q & 3;
    const float* pml = F.f32(WS_PARTML) + ((size_t)b * NSPLIT * 16 + q) * 2; const float* po = F.f32(WS_PARTO) + ((size_t)b * NSPLIT * 16 + q) * 256 + c0;
    float M = -INFINITY;
    for (int s = 0; s < NSPLIT; ++s) M = fmaxf(M, pml[(size_t)s * 32]);
    for (int kl = 0; kl < 4; ++kl) M = fmaxf(M, ss[q * 4 + kl]);
    float L = 0.f; float acc[8] = {0.f, 0.f, 0.f, 0.f, 0.f, 0.f, 0.f, 0.f};
    for (int s = 0; s < NSPLIT; ++s) {
        const float w = __builtin_amdgcn_exp2f(pml[(size_t)s * 32] - M); L += w * pml[(size_t)s * 32 + 1];
        const f32x4 a = *(const f32x4*)(po + (size_t)s * 4096), c = *(const f32x4*)(po + (size_t)s * 4096 + 4);
        acc[0] += w * a[0]; acc[1] += w * a[1]; acc[2] += w * a[2]; acc[3] += w * a[3]; acc[4] += w * c[0]; acc[5] += w * c[1]; acc[6] += w * c[2]; acc[7] += w * c[3];
    }
    for (int kl = 0; kl < 4; ++kl) {
        const float w = __builtin_amdgcn_exp2f(ss[q * 4 + kl] - M); L += w;
        for (int j = 0; j < 8; ++j) acc[j] += w * ckv[kl * 256 + c0 + j];
    }
    const float il = 1.0f / L;
    *(u32x4*)(F.b16(WS_MIXS) + (size_t)(b * 4 + lq) * 1536 + 512 + h * 256 + c0) = (u32x4){cvt_pk_bf16(acc[0] * il, acc[1] * il), cvt_pk_bf16(acc[2] * il, acc[3] * il), cvt_pk_bf16(acc[4] * il, acc[5] * il), cvt_pk_bf16(acc[6] * il, acc[7] * il)};
    __syncthreads();
}

__device__ __forceinline__ void conv_fix_panel(const Frame& F, int pm) {
    const float* conv_b = F.in(I_CONVB); const float* conv_w = F.in(I_CONVW); const bf16_t* uff = F.b16(WS_UFF); bf16_t* act = F.b16(WS_ACT);
    if (F.tid >= 352) return;
    const int j0 = F.tid * 8;
    float w[3][16], cb[16];
#pragma unroll
    for (int e = 0; e < 8; ++e) { cb[e] = conv_b[j0 + e]; cb[8 + e] = conv_b[DFF + j0 + e];
#pragma unroll
        for (int k = 0; k < 3; ++k) { w[k][e] = conv_w[(size_t)k * DFF2 + j0 + e]; w[k][8 + e] = conv_w[(size_t)k * DFF2 + DFF + j0 + e]; } }
#define CV_UNPACK(d, a_, g_) do { _Pragma("unroll") for (int e = 0; e < 4; ++e) { d[2 * e] = __uint_as_float(a_[e] << 16); d[2 * e + 1] = __uint_as_float(a_[e] & 0xffff0000u); d[8 + 2 * e] = __uint_as_float(g_[e] << 16); d[8 + 2 * e + 1] = __uint_as_float(g_[e] & 0xffff0000u); } } while (0)
#define CV_OUT(r_, um2, um1, u0) do { float o_[8]; _Pragma("unroll") for (int e = 0; e < 8; ++e) { \
            const float ca = cb[e] + w[0][e] * um2[e] + w[1][e] * um1[e] + w[2][e] * u0[e]; \
            const float cg = cb[8 + e] + w[0][8 + e] * um2[8 + e] + w[1][8 + e] * um1[8 + e] + w[2][8 + e] * u0[8 + e]; o_[e] = silu_f(cg) * ca; } \
        *(u32x4*)(act + (size_t)(r_) * DFF + j0) = (u32x4){cvt_pk_bf16(o_[0], o_[1]), cvt_pk_bf16(o_[2], o_[3]), cvt_pk_bf16(o_[4], o_[5]), cvt_pk_bf16(o_[6], o_[7])}; } while (0)
    u32x4 ra[4][4], rg[4][4];
#pragma unroll
    for (int k = 0; k < 4; ++k) { const int r0 = pm * 256 + 64 * k, t0 = r0 & 4095;
#pragma unroll
        for (int i = 0; i < 4; ++i) { const int r = i < 2 ? (t0 == 0 ? R_META + 14 + i : r0 - 2 + i) : r0 + i - 2;
            ra[k][i] = *(const u32x4*)(uff + (size_t)r * DFF2 + j0); rg[k][i] = *(const u32x4*)(uff + (size_t)r * DFF2 + DFF + j0); } }
#pragma unroll
    for (int k = 0; k < 4; ++k) { const int r0 = pm * 256 + 64 * k;
        float u0[16], u1[16], u2[16], u3[16];
        CV_UNPACK(u0, ra[k][0], rg[k][0]); CV_UNPACK(u1, ra[k][1], rg[k][1]); CV_UNPACK(u2, ra[k][2], rg[k][2]); CV_UNPACK(u3, ra[k][3], rg[k][3]);
        CV_OUT(r0, u0, u1, u2); CV_OUT(r0 + 1, u1, u2, u3); }
#undef CV_UNPACK
#undef CV_OUT
}

__device__ __forceinline__ void task_final(const Frame& F) {
    const float* g_final = F.in(I_GFINAL); const float* hp2 = F.f32(WS_HP2); const unsigned long long* sq = F.ssq(SSQ_F);
    for (int i = F.bid * 8 + F.wave; i < 16384 + 512; i += F.G * 8) {
        const int r = i < 16384 ? i : R_SAMP + (i - 16384);
        const float rstd = rstd_of(sq, r, 1.0f / 1024.0f);
        float* dst = i < 16384 ? F.out + O_YP + (size_t)i * 1024 : F.out + O_YS + (size_t)(i - 16384) * 1024;
#pragma unroll
        for (int k = 0; k < 4; ++k) { const int c = 4 * (F.lane + 64 * k); *(f32x4*)(dst + c) = *(const f32x4*)(hp2 + (size_t)r * 1024 + c) * rstd * *(const f32x4*)(g_final + c); }
    }
}

constexpr int NPHASE = 9;
template <int ONLY_PHASE> __global__ void __launch_bounds__(512, 2) fwd_kernel(Params prm) {
    extern __shared__ __attribute__((aligned(16))) unsigned char lds_raw[];
    Frame F; F.lds = (LAS unsigned char*)lds_raw; F.tid = threadIdx.x; F.lane = F.tid & 63; F.wave = __builtin_amdgcn_readfirstlane(F.tid >> 6);
    F.G = gridDim.x; F.bid = blockIdx.x; F.ws = prm.ws; F.out = prm.out; F.dup = 0;
    volatile LAS unsigned* misc = (volatile LAS unsigned*)(F.lds + LDS_MISC);
    if (F.tid < 4) misc[F.tid] = 0u;
    if (F.tid == 0) {
        LAS unsigned long long* pt = (LAS unsigned long long*)(F.lds + LDS_MISC + 64);
        pt[I_XP] = (unsigned long long)prm.x_prompt; pt[I_XS] = (unsigned long long)prm.x_sample; pt[I_CKV] = (unsigned long long)prm.cache_kv; pt[I_CPE] = (unsigned long long)prm.cache_pe;
        pt[I_SRET] = (unsigned long long)prm.state_ret; pt[I_SCONV] = (unsigned long long)prm.state_conv; pt[I_PT] = (unsigned long long)prm.page_table; pt[I_META] = (unsigned long long)prm.meta;
        pt[I_GMIX] = (unsigned long long)prm.g_mix; pt[I_WIN] = (unsigned long long)prm.w_in; pt[I_GQ] = (unsigned long long)prm.g_q; pt[I_WUQ] = (unsigned long long)prm.w_uq; pt[I_GKV] = (unsigned long long)prm.g_kv;
        pt[I_WUK] = (unsigned long long)prm.w_uk; pt[I_WUV] = (unsigned long long)prm.w_uv; pt[I_WOUT] = (unsigned long long)prm.w_out; pt[I_GFFN] = (unsigned long long)prm.g_ffn; pt[I_WUP] = (unsigned long long)prm.w_up;
        pt[I_CONVW] = (unsigned long long)prm.conv_w; pt[I_CONVB] = (unsigned long long)prm.conv_b; pt[I_WDOWN] = (unsigned long long)prm.w_down; pt[I_GFINAL] = (unsigned long long)prm.g_final;
    }
    __syncthreads();
    XcdBarrier bar; bar.bar = (unsigned*)(F.ws + WS_CTL); bar.x = 0; bar.st = misc;
    const int lo = ONLY_PHASE < 0 ? 0 : prm.ph_lo, hi = ONLY_PHASE < 0 ? NPHASE : prm.ph_hi;
    const bool fused = (hi - lo) > 1;
    if (fused) bar = xcd_barrier_post((unsigned*)(F.ws + WS_CTL), misc);
#define IN(k) ((ONLY_PHASE < 0 || ONLY_PHASE == (k)) && lo <= (k) && (k) < hi)
#define SEAM(k) do { if (IN(k) && IN((k) + 1)) xcd_barrier(bar); { int t_ = threadIdx.x; asm volatile("" : "+v"(t_)); F.tid = t_; F.lane = t_ & 63; F.wave = __builtin_amdgcn_readfirstlane(t_ >> 6); } } while (0)
    PG8_LAS unsigned char* glds = (PG8_LAS unsigned char*)lds_raw;

    if (IN(0)) { phase_prologue(F); if (PROBE_DUP & 1) { __syncthreads(); phase_prologue(F); } } SEAM(0);
    if (IN(1)) { for (int rep_ = 0; rep_ < ((PROBE_DUP & 64) ? 2 : 1); ++rep_) { F.dup = rep_;
        pg8::Gemm g{F.b16(WS_A0), F.b16(WS_BTIN), MP, 2816, 1024}; pg8::RowOrder S; S.init(67, 11, 0, F.G, F.bid); EpiIn E{F};
        pg8::gemm_phase<EpiIn, pg8::RowOrder>(glds, g, S, E);
     } F.dup = 0; } SEAM(1);
    if (IN(2)) { for (int rep_ = 0; rep_ < ((PROBE_DUP & 128) ? 2 : 1); ++rep_) { F.dup = rep_;
#ifndef P2M
#define P2M 31
#endif
        if (P2M & 1) { pg8::Gemm g{F.b16(WS_CQB), F.b16(WS_BTUQ), MP, 768, 384}; pg8::RowOrder S; S.init(65, 3, 0, F.G, F.bid); EpiUq E{F}; pg8::gemm_phase<EpiUq, pg8::RowOrder>(glds, g, S, E); }
        if (P2M & 2) { pg8::Gemm g{F.b16(WS_CQB), F.b16(WS_BTSQ), MP, 1280, 384}; pg8::RowOrder S; S.init(2, 5, 65, F.G, (F.bid + F.G - 195) % F.G); EpiSq E{F}; pg8::gemm_phase<EpiSq, pg8::RowOrder>(glds, g, S, E); }
        if (P2M & 4) { pg8::Gemm g{F.b16(WS_CKVB), F.b16(WS_BTKV), MP, 1024, 256}; pg8::RowOrder S; S.init(65, 4, 0, F.G, (F.bid + F.G - 205) % F.G); EpiKv E{F}; pg8::gemm_phase<EpiKv, pg8::RowOrder>(glds, g, S, E); }
        if (P2M & 8) task_kvlat(F);
     } F.dup = 0; } SEAM(2);
    if (IN(4)) {
        unsigned* qctr = (unsigned*)(F.ws + WS_CTL + 16384);
        const int role = (F.bid >> 3) & 1;
#define Q_PULL(qi, var) if (F.tid == 0) misc[2] = __hip_atomic_fetch_add(qctr + 64 * (qi), 1u, __ATOMIC_RELAXED, __HIP_MEMORY_SCOPE_AGENT); __syncthreads(); const int var = __builtin_amdgcn_readfirstlane((int)misc[2]); __syncthreads()
#define Q_COMPUTE() do { _Pragma("unroll 1") for (;;) { Q_PULL(4, i); if (i >= 128) break; retscan_item(F, i); }     \
                         _Pragma("unroll 1") for (;;) { Q_PULL(5, i); if (i >= 516) break; if (i < 512) sample_ret_item(F, i); else meta_ret_item(F, i - 512); } \
                           \
                         _Pragma("unroll 1") for (int gen_ = 0; ; ++gen_) { int j_; \
                             if (F.G == 256) { if (role != 0 || gen_ >= 2) break; const int x_ = F.bid & 7, i_ = F.bid >> 4, pp_ = gen_ ? 15 - (i_ & 7) : (i_ & 7); j_ = pp_ * 16 + 2 * x_ + (i_ >> 3); } \
                             else { j_ = F.bid + gen_ * F.G; if (j_ >= 256) break; }     \
                             attn_unit(F, j_); __syncthreads(); } \
                         _Pragma("unroll 1") for (;;) { Q_PULL(0, i); if (i >= 4) break; if (F.wave == 0) attn_wave(F, 0, i, R_META, 0); __syncthreads(); } \
                         _Pragma("unroll 1") for (;;) { Q_PULL(1, i); if (i >= 512) break; ret_unit(F, i); } } while (0)
#define Q_DECODE() decode_stream(F, qctr + 64 * 2, misc)
        if (role == 0) { Q_COMPUTE(); Q_DECODE(); } else { Q_DECODE(); Q_COMPUTE(); }
#pragma unroll 1
        for (;;) { Q_PULL(3, bq); if (bq >= DB) break;
            if (F.tid == 0) { unsigned* cb_ = (unsigned*)(F.ws + WS_CTL + 53248) + 16 * bq; unsigned sp = 0;
                while (__hip_atomic_load(cb_, __ATOMIC_RELAXED, __HIP_MEMORY_SCOPE_AGENT) < (unsigned)NSPLIT) { __builtin_amdgcn_s_sleep(2); if (++sp > (1u << 22)) { __hip_atomic_store((unsigned*)(F.ws + WS_CTL) + XB_TMO, 1u, __ATOMIC_RELAXED, __HIP_MEMORY_SCOPE_AGENT); break; } }
                __builtin_amdgcn_fence(__ATOMIC_ACQUIRE, "agent"); asm volatile("s_waitcnt vmcnt(0)" ::: "memory"); }
            __syncthreads();
            combine_item(F, bq); }
#undef Q_COMPUTE
#undef Q_DECODE
#undef Q_PULL
    } SEAM(4);
    if (IN(6)) { for (int rep_ = 0; rep_ < ((PROBE_DUP & 256) ? 2 : 1); ++rep_) { F.dup = rep_;
        { pg8::Gemm g{F.b16(WS_MIXA), F.b16(WS_BTOUT), MP, 1024, 1024}; pg8::RowOrder S; S.init(64, 4, 0, F.G, F.bid); EpiOut E{F}; pg8::gemm_phase<EpiOut, pg8::RowOrder>(glds, g, S, E); }
        for (int u = F.bid; u < 272; u += F.G) {
            if (u < 256) { const int rt = u >> 4, ct = u & 15; SEpiOut E{F.in(I_XS) - (size_t)R_SAMP * 1024, F.b16(WS_HPB), F.ssqw(SSQ_H), MP};
                small_gemm_unit<4>(F, F.b16(WS_MIXS) + (size_t)rt * 32 * 1536, F.b16(WS_BTOUTS) + (size_t)ct * 64 * 1536, 1536, R_SAMP + rt * 32, ct * 64, E); }
            else { const int ct = u - 256; SEpiOut E{F.in(I_META) - (size_t)R_META * 1024, F.b16(WS_HPB), F.ssqw(SSQ_H), R_META + NMETA - 1};
                small_gemm_unit<4>(F, F.b16(WS_MIXA) + (size_t)R_META * 1024, F.b16(WS_BTOUT) + (size_t)ct * 64 * 1024, 1024, R_META, ct * 64, E); }
        }
     } F.dup = 0; } SEAM(6);
    if (IN(7)) { for (int rep_ = 0; rep_ < ((PROBE_DUP & 512) ? 2 : 1); ++rep_) { F.dup = rep_;
        pg8::Gemm g{F.b16(WS_HPB), F.b16(WS_BTUP), MP, 5632, 1024}; EpiUp E{F};
#pragma unroll 1
        for (int part = 0; part < 2; ++part) { pg8::RowOrder S; if (part == 0) S.init(64, 22, 0, F.G, F.bid); else S.init(3, 22, 64, F.G, (F.bid + 128) % F.G);
            pg8::gemm_phase<EpiUp, pg8::RowOrder>(glds, g, S, E); }
     } F.dup = 0; } SEAM(7);
    if (IN(8)) {
        { pg8::Gemm g{F.b16(WS_ACT), F.b16(WS_BTDN), MP, 1024, 2816}; pg8::RowOrder S; S.init(64, 4, 0, F.G, F.bid); EpiDownNorm E{F};
          { pg8::Unit u0; if (S.next(0, u0)) conv_fix_panel(F, u0.pm); asm volatile("s_waitcnt vmcnt(0)" ::: "memory"); __syncthreads(); }
          pg8::gemm_phase<EpiDownNorm, pg8::RowOrder>(glds, g, S, E); }
        for (int u = F.bid; u < 256; u += F.G) { const int rt = u >> 4, ct = u & 15;
            SEpiDownNorm E{F.b16(WS_HPB), F.in(I_GFINAL), F.out + O_YS, F.ssq(SSQ_F), (unsigned*)(F.ws + WS_CTL + 32768) + 64 * (64 + rt), (unsigned*)(F.ws + WS_CTL) + XB_TMO};
            small_gemm_unit<4>(F, F.b16(WS_ACT) + (size_t)(R_SAMP + rt * 32) * 2816, F.b16(WS_BTDN) + (size_t)ct * 64 * 2816, 2816, R_SAMP + rt * 32, ct * 64, E); }
    }
#undef IN
#undef SEAM
}

template <int PH> static void launch_phase(Params p, int grid, hipStream_t stream) {
    static bool attr = false;
    if (!attr) { (void)hipFuncSetAttribute((const void*)fwd_kernel<PH>, hipFuncAttributeMaxDynamicSharedMemorySize, LDS_BYTES); attr = true; }
    if (PH >= 0) { p.ph_lo = PH; p.ph_hi = PH + 1; } else { p.ph_lo = 0; p.ph_hi = NPHASE; }
    hipLaunchKernelGGL(fwd_kernel<PH>, dim3(grid), dim3(512), LDS_BYTES, stream, p);
}

extern "C" void kernel_launch(void* const* d_in, const int* in_sizes, int n_in, void* d_out, int out_size, void* d_ws, size_t ws_size, hipStream_t stream) {
    static int grid = 0;
    if (grid == 0) {
        int dev = 0, cus = 0;
        (void)hipGetDevice(&dev); (void)hipDeviceGetAttribute(&cus, hipDeviceAttributeMultiprocessorCount, dev);
        grid = cus > 0 ? cus : 256;
    }
    (void)hipMemsetAsync((char*)d_ws + WS_CTL, 0, WS_ZERO_BYTES, stream);
    Params p{};
    p.x_prompt = (const float*)d_in[0]; p.x_sample = (const float*)d_in[1]; p.cache_kv = (const float*)d_in[2]; p.cache_pe = (const float*)d_in[3];
    p.state_ret = (const float*)d_in[4]; p.state_conv = (const float*)d_in[5]; p.page_table = (const int*)d_in[6]; p.meta = (const float*)d_in[7];
    p.g_mix = (const float*)d_in[8]; p.w_in = (const float*)d_in[9]; p.g_q = (const float*)d_in[10]; p.w_uq = (const float*)d_in[11]; p.g_kv = (const float*)d_in[12];
    p.w_uk = (const float*)d_in[13]; p.w_uv = (const float*)d_in[14]; p.w_out = (const float*)d_in[15]; p.g_ffn = (const float*)d_in[16]; p.w_up = (const float*)d_in[17];
    p.conv_w = (const float*)d_in[18]; p.conv_b = (const float*)d_in[19]; p.w_down = (const float*)d_in[20]; p.g_final = (const float*)d_in[21];
    p.out = (float*)d_out; p.ws = (unsigned char*)d_ws;
#if N_LAUNCH_PER_PHASE
#ifndef PROBE_PH
#define PROBE_PH -1
#endif
#define LP(k) do { launch_phase<k>(p, grid, stream); if (PROBE_PH == (k)) { (void)hipMemsetAsync((char*)d_ws + WS_CTL + 16384, 0, 65536 - 16384, stream); \
        if ((k) == 1) (void)hipMemsetAsync((char*)d_ws + WS_SSQ, 0, (size_t)2 * MP * 8, stream); \
        if ((k) == 6) (void)hipMemsetAsync((char*)d_ws + WS_SSQ + (size_t)2 * MP * 8, 0, (size_t)MP * 8, stream); \
        if ((k) == 8) (void)hipMemsetAsync((char*)d_ws + WS_SSQ + (size_t)3 * MP * 8, 0, (size_t)MP * 8, stream); \
        launch_phase<k>(p, grid, stream); } } while (0)
    LP(0); LP(1); LP(2); LP(4); LP(6); LP(7); LP(8);
#undef LP
#else
    launch_phase<-1>(p, grid, stream);
#endif
}
```
